# Optimizing an MI355X kernel written in HIP

```python
import math
import jax
import jax.numpy as jnp
from jax import lax
import numpy as np

D_MODEL = 1024
BATCH = 16
SEQ = 2048
DEPTH = 4

CTX_LEN = 256
GRID_W = 64
D_SSM = D_MODEL // 2
SSM_GROUP = 16
N_SSM_GROUPS = D_SSM // SSM_GROUP
SSM_STATE = 64
SSM_DT_MIN = 1e-3
SSM_DT_MAX = 1e-1
N_HEADS = 4
QK_HEAD_DIM = 64
V_HEAD_DIM = 2 * QK_HEAD_DIM
D_QK = N_HEADS * 2 * QK_HEAD_DIM
D_V = N_HEADS * V_HEAD_DIM
ROPE_BASE = 10000.0
ROPE_AXIS_FREQS = QK_HEAD_DIM // 4
Q_BLOCK = 128
IN_SPLITS = (D_SSM, D_SSM + D_QK, D_SSM + 2 * D_QK, D_SSM + 2 * D_QK + D_V, D_SSM + 2 * D_QK + D_V + D_MODEL)
IN_COLS = D_SSM + 2 * D_QK + D_V + 2 * D_MODEL
N_EXPERTS = 16
N_EXPERT_GROUPS = 4
EXPERTS_PER_GROUP = N_EXPERTS // N_EXPERT_GROUPS
TOP_K = 2
D_EXPERT = D_MODEL
MOE_BLOCK = 128
NORM_EPS = 1e-6
SUBLN_EPS = 1e-5

kernel_name = 'hybrid_s5_diffattn_groupmoe_dit'


def rmsnorm(x, g, eps=NORM_EPS):
    xf = x.astype(jnp.float32)
    y = xf * lax.rsqrt(jnp.mean(xf * xf, axis=-1, keepdims=True) + eps)
    return y.astype(x.dtype) * g


def axial_rope_tables(rows):
    row = jnp.repeat(jnp.arange(rows), GRID_W).astype(jnp.float32)
    col = jnp.tile(jnp.arange(GRID_W), rows).astype(jnp.float32)
    inv = ROPE_BASE ** (-jnp.arange(ROPE_AXIS_FREQS, dtype=jnp.float32) / ROPE_AXIS_FREQS)
    ang_r = row[:, None] * inv
    ang_c = col[:, None] * inv
    ang = jnp.concatenate([ang_r, ang_r, ang_c, ang_c], axis=-1)
    return jnp.cos(ang), jnp.sin(ang)


def apply_axial_rope(t, cos, sin):
    shp = t.shape
    tt = t.reshape(shp[:-1] + (2, 2, ROPE_AXIS_FREQS))
    rot = jnp.stack([-tt[..., 1, :], tt[..., 0, :]], axis=-2).reshape(shp)
    cs = cos[None, :, None, None, :].astype(t.dtype)
    sn = sin[None, :, None, None, :].astype(t.dtype)
    return t * cs + rot * sn


def s5_discretize(lam_re, lam_im, log_dt, b_re, b_im):
    lr = lam_re.astype(jnp.float32)
    li = lam_im.astype(jnp.float32)
    dt = jnp.exp(log_dt.astype(jnp.float32))[:, None]
    decay = jnp.exp(lr * dt)
    ab_re = decay * jnp.cos(li * dt)
    ab_im = decay * jnp.sin(li * dt)
    den = lr * lr + li * li
    nr = ab_re - 1.0
    ni = ab_im
    cr = ((nr * lr + ni * li) / den)[..., None]
    ci = ((ni * lr - nr * li) / den)[..., None]
    br = b_re.astype(jnp.float32)
    bi = b_im.astype(jnp.float32)
    return ab_re, ab_im, cr * br - ci * bi, cr * bi + ci * br


def _linear_recurrence_combine(left, right):
    a1r, a1i, b1r, b1i = left
    a2r, a2i, b2r, b2i = right
    return (a2r * a1r - a2i * a1i,
            a2r * a1i + a2i * a1r,
            a2r * b1r - a2i * b1i + b2r,
            a2r * b1i + a2i * b1r + b2i)


def s5_scan(u_g, ab_re, ab_im, bb_re, bb_im, h0, reverse):
    uf = u_g.astype(jnp.float32)
    bu_re = jnp.einsum('blgh,gph->blgp', uf, bb_re)
    bu_im = jnp.einsum('blgh,gph->blgp', uf, bb_im)
    if h0 is not None:
        pos = u_g.shape[1] - 1 if reverse else 0
        h0_re, h0_im = h0
        bu_re = bu_re.at[:, pos].add(ab_re * h0_re - ab_im * h0_im)
        bu_im = bu_im.at[:, pos].add(ab_re * h0_im + ab_im * h0_re)
    shape = (1, u_g.shape[1]) + ab_re.shape
    a_re = jnp.broadcast_to(ab_re, shape)
    a_im = jnp.broadcast_to(ab_im, shape)
    _, _, h_re, h_im = lax.associative_scan(_linear_recurrence_combine, (a_re, a_im, bu_re, bu_im),
                                            reverse=reverse, axis=1)
    return h_re, h_im


def s5_readout(h_re, h_im, c_re, c_im):
    return (jnp.einsum('blgp,ghp->blgh', h_re, c_re.astype(jnp.float32))
            - jnp.einsum('blgp,ghp->blgh', h_im, c_im.astype(jnp.float32)))


def s5_glu(y, w_glu):
    a, b = jnp.split(jax.nn.gelu(y) @ w_glu, 2, axis=-1)
    return a * jax.nn.sigmoid(b)


def s5_branch(u, uc, lam_re, lam_im, log_dt, b_re, b_im, c_re, c_im, d_skip, w_glu, ctx_out):
    B, S, _ = u.shape
    Lc = uc.shape[1]
    u_g = u.reshape(B, S, N_SSM_GROUPS, SSM_GROUP)
    uc_g = uc.reshape(B, Lc, N_SSM_GROUPS, SSM_GROUP)
    y = d_skip * u
    yc = d_skip * uc if ctx_out else None
    for dirn, reverse in ((0, False), (1, True)):
        ab_re, ab_im, bb_re, bb_im = s5_discretize(lam_re[dirn], lam_im[dirn], log_dt[dirn], b_re[dirn], b_im[dirn])
        hc_re, hc_im = s5_scan(uc_g, ab_re, ab_im, bb_re, bb_im, None, reverse)
        last = 0 if reverse else Lc - 1
        h_re, h_im = s5_scan(u_g, ab_re, ab_im, bb_re, bb_im, (hc_re[:, last], hc_im[:, last]), reverse)
        y = y + s5_readout(h_re, h_im, c_re[dirn], c_im[dirn]).reshape(B, S, D_SSM).astype(u.dtype)
        if ctx_out:
            yc = yc + s5_readout(hc_re, hc_im, c_re[dirn], c_im[dirn]).reshape(B, Lc, D_SSM).astype(u.dtype)
    return s5_glu(y, w_glu), (s5_glu(yc, w_glu) if ctx_out else None)


def diff_attn_core(q, k, v, lam):
    s = jnp.einsum('bqhmd,bkhmd->bhmqk', q, k).astype(jnp.float32) * (QK_HEAD_DIM ** -0.5)
    p = jax.nn.softmax(s, axis=-1)
    a = p[:, :, 0] - lam * p[:, :, 1]
    return jnp.einsum('bhqk,bkhd->bqhd', a.astype(v.dtype), v)


def diff_attention_branch(q, k, v, qc, kc, vc, lam_vec, lam_init, subln_g, w_attn_out, cos, sin, ctx_out):
    B, S, _ = q.shape
    Lc = kc.shape[1]
    q = apply_axial_rope(q.reshape(B, S, N_HEADS, 2, QK_HEAD_DIM), cos, sin)
    k = apply_axial_rope(k.reshape(B, S, N_HEADS, 2, QK_HEAD_DIM), cos, sin)
    v = v.reshape(B, S, N_HEADS, V_HEAD_DIM)
    kc = kc.reshape(B, Lc, N_HEADS, 2, QK_HEAD_DIM)
    vc = vc.reshape(B, Lc, N_HEADS, V_HEAD_DIM)
    lf = lam_vec.astype(jnp.float32)
    lam = jnp.exp(jnp.sum(lf[0] * lf[1])) - jnp.exp(jnp.sum(lf[2] * lf[3])) + lam_init
    k_all = jnp.concatenate([kc, k], axis=1)
    v_all = jnp.concatenate([vc, v], axis=1)
    n_blk = S // Q_BLOCK
    qb = jnp.moveaxis(q.reshape(B, n_blk, Q_BLOCK, N_HEADS, 2, QK_HEAD_DIM), 1, 0)
    ob = lax.map(lambda qi: diff_attn_core(qi, k_all, v_all, lam), qb)
    o = jnp.moveaxis(ob, 0, 1).reshape(B, S, N_HEADS, V_HEAD_DIM)

    def post(t):
        t = rmsnorm(t, subln_g, SUBLN_EPS) * (1.0 - lam_init)
        return t.reshape(t.shape[0], t.shape[1], D_V) @ w_attn_out

    out = post(o)
    if ctx_out:
        oc = diff_attn_core(qc.reshape(B, Lc, N_HEADS, 2, QK_HEAD_DIM), kc, vc, lam)
        return out, post(oc)
    return out, None


def grouped_experts(t, eidx, gate_w, w1, w3, w2):
    T, D = t.shape
    n_assign = T * TOP_K
    e_flat = eidx.reshape(-1)
    tok_flat = jnp.arange(n_assign) // TOP_K
    w_flat = gate_w.reshape(-1)
    order = jnp.argsort(e_flat)
    e_sorted = e_flat[order]
    counts = jnp.bincount(e_flat, length=N_EXPERTS)
    padded = (counts + MOE_BLOCK - 1) // MOE_BLOCK * MOE_BLOCK
    start = jnp.cumsum(counts) - counts
    pend = jnp.cumsum(padded)
    pstart = pend - padded
    dest = pstart[e_sorted] + (jnp.arange(n_assign) - start[e_sorted])
    n_blocks = (n_assign + N_EXPERTS * (MOE_BLOCK - 1) + MOE_BLOCK - 1) // MOE_BLOCK
    cap = n_blocks * MOE_BLOCK
    slot_tok = jnp.full((cap,), T, jnp.int32).at[dest].set(tok_flat[order].astype(jnp.int32))
    slot_w = jnp.zeros((cap,), t.dtype).at[dest].set(w_flat[order].astype(t.dtype))
    block_exp = jnp.minimum(jnp.searchsorted(pend, jnp.arange(n_blocks) * MOE_BLOCK, side='right'), N_EXPERTS - 1)
    t_pad = jnp.concatenate([t, jnp.zeros((1, D), t.dtype)], axis=0)
    xb = t_pad[slot_tok].reshape(n_blocks, MOE_BLOCK, D)

    def expert_block(args):
        xe, e = args
        hid = jax.nn.silu(xe @ w1[e]) * (xe @ w3[e])
        return hid @ w2[e]

    yb = lax.map(expert_block, (xb, block_exp)).reshape(cap, D)
    out = jnp.zeros((T + 1, D), t.dtype).at[slot_tok].add(yb * slot_w[:, None])
    return out[:T]


def moe_ffn(t, router_w, router_b, w1, w3, w2):
    T = t.shape[0]
    logits = t.astype(jnp.float32) @ router_w.astype(jnp.float32)
    aff = jax.nn.sigmoid(logits)
    sel = aff + router_b.astype(jnp.float32)
    group_score = lax.top_k(sel.reshape(T, N_EXPERT_GROUPS, EXPERTS_PER_GROUP), 2)[0].sum(-1)
    g_sel = jnp.argmax(group_score, axis=-1)
    in_group = (jnp.arange(N_EXPERTS) // EXPERTS_PER_GROUP)[None, :] == g_sel[:, None]
    _, eidx = lax.top_k(jnp.where(in_group, sel, -jnp.inf), TOP_K)
    w = jnp.take_along_axis(aff, eidx, axis=-1)
    w = w / jnp.sum(w, axis=-1, keepdims=True)
    return grouped_experts(t, eidx, w, w1, w3, w2)


def setup_inputs(seed: int = 0) -> dict:
    key = jax.random.key(seed)
    ks = jax.random.split(key, 32)
    f32 = jnp.float32

    def nrm(k, shape, s):
        return jax.random.normal(k, shape, f32) * s

    lam_shape = (DEPTH, 2, N_SSM_GROUPS, SSM_STATE)
    n_idx = jnp.arange(SSM_STATE, dtype=f32)
    return {
        'x': nrm(ks[0], (BATCH, SEQ, D_MODEL), 1.0),
        'c': nrm(ks[1], (BATCH, D_MODEL), 1.0),
        'ctx': nrm(ks[2], (BATCH, CTX_LEN, D_MODEL), 1.0),
        'c_ctx': nrm(ks[3], (D_MODEL,), 1.0),
        'ada_w': nrm(ks[4], (DEPTH, D_MODEL, 6 * D_MODEL), 0.5 * D_MODEL ** -0.5),
        'ada_b': nrm(ks[5], (DEPTH, 6 * D_MODEL), 0.02),
        'norm1_g': 1.0 + nrm(ks[6], (DEPTH, D_MODEL), 0.02),
        'norm2_g': 1.0 + nrm(ks[7], (DEPTH, D_MODEL), 0.02),
        'final_g': 1.0 + nrm(ks[8], (D_MODEL,), 0.02),
        'w_in': nrm(ks[9], (DEPTH, D_MODEL, IN_COLS), D_MODEL ** -0.5),
        'ssm_lam_re': -0.5 + nrm(ks[10], lam_shape, 0.01),
        'ssm_lam_im': math.pi * n_idx + nrm(ks[11], lam_shape, 0.01),
        'ssm_log_dt': jax.random.uniform(ks[12], (DEPTH, 2, N_SSM_GROUPS), f32,
                                         math.log(SSM_DT_MIN), math.log(SSM_DT_MAX)),
        'ssm_b_re': nrm(ks[13], (DEPTH, 2, N_SSM_GROUPS, SSM_STATE, SSM_GROUP), (2 * SSM_GROUP) ** -0.5),
        'ssm_b_im': nrm(ks[14], (DEPTH, 2, N_SSM_GROUPS, SSM_STATE, SSM_GROUP), (2 * SSM_GROUP) ** -0.5),
        'ssm_c_re': nrm(ks[15], (DEPTH, 2, N_SSM_GROUPS, SSM_GROUP, SSM_STATE), SSM_STATE ** -0.5),
        'ssm_c_im': nrm(ks[16], (DEPTH, 2, N_SSM_GROUPS, SSM_GROUP, SSM_STATE), SSM_STATE ** -0.5),
        'ssm_d': nrm(ks[17], (DEPTH, D_SSM), 1.0),
        'w_glu': nrm(ks[18], (DEPTH, D_SSM, 2 * D_MODEL), D_SSM ** -0.5),
        'attn_lambda': nrm(ks[19], (DEPTH, 4, QK_HEAD_DIM), 0.1),
        'attn_subln_g': 1.0 + nrm(ks[20], (DEPTH, V_HEAD_DIM), 0.02),
        'w_attn_out': nrm(ks[21], (DEPTH, D_V, D_MODEL), D_V ** -0.5),
        'w_o': nrm(ks[22], (DEPTH, D_MODEL, D_MODEL), D_MODEL ** -0.5),
        'router_w': nrm(ks[23], (D_MODEL, N_EXPERTS), D_MODEL ** -0.5),
        'router_b': nrm(ks[24], (N_EXPERTS,), 0.01),
        'exp_w1': nrm(ks[25], (DEPTH, N_EXPERTS, D_MODEL, D_EXPERT), D_MODEL ** -0.5),
        'exp_w3': nrm(ks[26], (DEPTH, N_EXPERTS, D_MODEL, D_EXPERT), D_MODEL ** -0.5),
        'exp_w2': nrm(ks[27], (DEPTH, N_EXPERTS, D_EXPERT, D_MODEL), D_EXPERT ** -0.5),
    }


def reference(x, c, ctx, c_ctx, ada_w, ada_b, norm1_g, norm2_g, final_g, w_in,
              ssm_lam_re, ssm_lam_im, ssm_log_dt, ssm_b_re, ssm_b_im, ssm_c_re, ssm_c_im, ssm_d, w_glu,
              attn_lambda, attn_subln_g, w_attn_out, w_o, router_w, router_b, exp_w1, exp_w3, exp_w2):
    B, S, D = x.shape
    Lc = ctx.shape[1]
    rows = S // GRID_W
    cos, sin = axial_rope_tables(rows)
    silu_c = jax.nn.silu(c)
    silu_cc = jax.nn.silu(c_ctx)
    xc = ctx
    for l in range(DEPTH):
        ctx_out = l < DEPTH - 1
        lam_init = 0.8 - 0.6 * math.exp(-0.3 * l)
        sh1, sc1, g1, sh2, sc2, g2 = [m[:, None, :] for m in jnp.split(silu_c @ ada_w[l] + ada_b[l], 6, axis=-1)]
        csh1, csc1, cg1, csh2, csc2, cg2 = jnp.split(silu_cc @ ada_w[l] + ada_b[l], 6, axis=-1)

        h = rmsnorm(x, norm1_g[l]) * (1.0 + sc1) + sh1
        hc = rmsnorm(xc, norm1_g[l]) * (1.0 + csc1) + csh1
        u, q, k, v, gs, ga = jnp.split(h @ w_in[l], IN_SPLITS, axis=-1)
        uc, qc, kc, vc, gsc, gac = jnp.split(hc @ w_in[l], IN_SPLITS, axis=-1)
        p_s, p_sc = s5_branch(u, uc, ssm_lam_re[l], ssm_lam_im[l], ssm_log_dt[l], ssm_b_re[l], ssm_b_im[l],
                              ssm_c_re[l], ssm_c_im[l], ssm_d[l], w_glu[l], ctx_out)
        p_a, p_ac = diff_attention_branch(q, k, v, qc, kc, vc, attn_lambda[l], lam_init, attn_subln_g[l],
                                          w_attn_out[l], cos, sin, ctx_out)
        x = x + g1 * ((jax.nn.sigmoid(gs) * p_s + jax.nn.sigmoid(ga) * p_a) @ w_o[l])

        h2 = rmsnorm(x, norm2_g[l]) * (1.0 + sc2) + sh2
        if ctx_out:
            xc = xc + cg1 * ((jax.nn.sigmoid(gsc) * p_sc + jax.nn.sigmoid(gac) * p_ac) @ w_o[l])
            h2c = rmsnorm(xc, norm2_g[l]) * (1.0 + csc2) + csh2
            tokens = jnp.concatenate([h2.reshape(B * S, D), h2c.reshape(B * Lc, D)], axis=0)
            f = moe_ffn(tokens, router_w, router_b, exp_w1[l], exp_w3[l], exp_w2[l])
            x = x + g2 * f[:B * S].reshape(B, S, D)
            xc = xc + cg2 * f[B * S:].reshape(B, Lc, D)
        else:
            f = moe_ffn(h2.reshape(B * S, D), router_w, router_b, exp_w1[l], exp_w3[l], exp_w2[l])
            x = x + g2 * f.reshape(B, S, D)
    return rmsnorm(x, final_g)
```

```cpp
#include <hip/hip_runtime.h>
#include <cstdio>
#include <cstdint>

#define GAS __attribute__((address_space(1)))
#define LAS __attribute__((address_space(3)))
typedef unsigned short bf16;
typedef short bf16x8 __attribute__((ext_vector_type(8)));
typedef float f32x4 __attribute__((ext_vector_type(4)));
typedef float f32x2 __attribute__((ext_vector_type(2)));
typedef unsigned u32x4 __attribute__((ext_vector_type(4)));
typedef unsigned u32x2 __attribute__((ext_vector_type(2)));

constexpr int D = 1024, NB = 16, SEQ = 2048, LC = 256, DEPTH = 4;
constexpr int TL = NB * SEQ, TC = NB * LC, T = TL + TC;
constexpr int NCOL = 4096;
constexpr int CU_ = 0, CQ = 512, CK = 1024, CV = 1536, CGS = 2048, CGA = 3072;
constexpr int NG = 32, NE = 16;
constexpr float NORM_EPS = 1e-6f, SUBLN_EPS = 1e-5f;
constexpr float QSCALE = 0.125f * 1.4426950408889634f;
constexpr int NWAVES = 8, NTHREADS = 512;

constexpr size_t MiB = 1u << 20;
constexpr size_t WS_CTL = 0, CTL_ZERO_BYTES = 1 * MiB;
constexpr size_t WS_MODS = 1 * MiB;
constexpr size_t WS_ROPE = 3 * MiB;
constexpr size_t WS_TOKINFO = 4 * MiB;
constexpr size_t WS_TOKW = 4 * MiB + 512 * 1024;
constexpr size_t WS_LIST = 5 * MiB;
constexpr size_t WS_WIN = 8 * MiB, WS_WGLU = 16 * MiB, WS_WAO = 18 * MiB, WS_WO = 19 * MiB, WS_W13 = 24 * MiB, WS_W2 = 88 * MiB;
constexpr size_t WS_XRES = 120 * MiB;
constexpr size_t WS_H = 264 * MiB;
constexpr size_t WS_P = 336 * MiB;
constexpr size_t WS_HID = 336 * MiB, WS_YS = 488 * MiB;
constexpr size_t WS_YG = 640 * MiB, WS_ON = 676 * MiB, WS_YF = 712 * MiB, WS_YB = 748 * MiB;
constexpr size_t WS_MG = 784 * MiB;
constexpr size_t WS_WALT = 848 * MiB;
constexpr size_t WS_END = 968 * MiB;
constexpr int CW_BAR = 4096;
constexpr int CW_CNT = 16384;

constexpr int RING_BYTES = 131072, RC_OFF = 131072, RC_BYTES = 16384, MISC_OFF = RC_OFF + RC_BYTES, LDS_BYTES = MISC_OFF + 1024;

__device__ __forceinline__ unsigned f2bf(float f) { unsigned u = __builtin_bit_cast(unsigned, f); return (u + 0x7fffu + ((u >> 16) & 1u)) >> 16; }
__device__ __forceinline__ unsigned pk2(float lo, float hi) { unsigned r; asm("v_cvt_pk_bf16_f32 %0, %1, %2" : "=v"(r) : "v"(lo), "v"(hi)); return r; }
__device__ __forceinline__ float bflo(unsigned w) { return __builtin_bit_cast(float, w << 16); }
__device__ __forceinline__ float bfhi(unsigned w) { return __builtin_bit_cast(float, w & 0xffff0000u); }
__device__ __forceinline__ float u8f(unsigned w, int b) { return (float)((w >> (8 * b)) & 0xffu) * (1.0f / 255.0f); }
__device__ __forceinline__ float bf2f(bf16 b) { return __builtin_bit_cast(float, ((unsigned)b) << 16); }
__device__ __forceinline__ float sigmoidf_(float x) { return __builtin_amdgcn_rcpf(1.0f + __builtin_amdgcn_exp2f(-1.4426950408889634f * x)); }
template <int O> __device__ __forceinline__ float xor_lane(float v) { const int iv = __float_as_int(v); return __int_as_float(__builtin_amdgcn_ds_swizzle(iv, (O << 10) | 0x1f)); }
__device__ __forceinline__ float sum_xor32(float v) { const auto rr = __builtin_amdgcn_permlane32_swap(__float_as_uint(v), __float_as_uint(v), false, false); return __uint_as_float(rr[0]) + __uint_as_float(rr[1]); }
__device__ __forceinline__ float other_half(float v, bool hi) { const auto rr = __builtin_amdgcn_permlane32_swap(__float_as_uint(v), __float_as_uint(v), false, false); return hi ? __uint_as_float(rr[0]) : __uint_as_float(rr[1]); }
__device__ __forceinline__ float wave_sum(float v) {
    v += xor_lane<1>(v); v += xor_lane<2>(v); v += xor_lane<4>(v); v += xor_lane<8>(v); v += xor_lane<16>(v);
    return sum_xor32(v);
}
__device__ __forceinline__ unsigned pk4_fp8(float a, float b, float c, float d) {
    a = __builtin_amdgcn_fmed3f(a, -448.f, 448.f); b = __builtin_amdgcn_fmed3f(b, -448.f, 448.f); c = __builtin_amdgcn_fmed3f(c, -448.f, 448.f); d = __builtin_amdgcn_fmed3f(d, -448.f, 448.f);
    int w = 0; w = __builtin_amdgcn_cvt_pk_fp8_f32(a, b, w, false); w = __builtin_amdgcn_cvt_pk_fp8_f32(c, d, w, true); return (unsigned)w; }
constexpr float F8_SY = 16.f;
constexpr float F8_SX = 8.f, F8_SH = 16.f, F8_SW = 64.f;
constexpr int F8_EX = 0x7c7c7c7c, F8_EH = 0x7b7b7b7b, F8_EW = 0x79797979;
#define LDS_WAIT() asm volatile("s_waitcnt lgkmcnt(0)" ::: "memory")
#define VM_WAIT() asm volatile("s_waitcnt vmcnt(0)" ::: "memory")

namespace pg8 {
#define PG8_LAS __attribute__((address_space(3)))
typedef unsigned short bf16_t;
constexpr int BM = 256, BK = 64, HALF = 128, HTB = HALF * BK * 2, STAGE_BYTES = 8 * HTB, NXCD = 8, WGM = 8;
__host__ __device__ __forceinline__ int lds_byte(int r, int c) { const int st = (r >> 4) * 2 + (c >> 5), rr = r & 15, cc = c & 31, ob = rr * 64 + cc * 2; return st * 1024 + (ob ^ (((ob >> 9) & 1) << 5)); }
__host__ __device__ __forceinline__ void stage_rc(int b, int& R, int& C) { const int st = b / 1024, sb = b % 1024, swz = sb ^ (((sb >> 9) & 1) << 5); R = (st >> 1) * 16 + swz / 64; C = (st & 1) * 32 + (swz % 64) / 2; }
__host__ __device__ __forceinline__ int perm32(int rho) { const int n = rho >> 4, i = rho & 15; return 8 * (i >> 2) + 4 * n + (i & 3); }

struct Unit { int pm, pn, e, li; };
struct Gemm { const bf16_t* A; const bf16_t* Bt; int M, N, K; int sa, sb; };

struct StaticOrder {
    int nM, nN, nwg, G, c;
    __device__ void init(int M, int N, int G_, int c_) { nM = M / BM; nN = N / BM; nwg = nM * nN; G = G_; c = c_; }
    __device__ bool next(int i, Unit& u) const {
        const long L = (long)i * G + c; if (L >= nwg) return false;
        int wgid = (int)L; { const int q = nwg / NXCD, r = nwg % NXCD, xcd = wgid % NXCD, off = wgid / NXCD; wgid = (xcd < r ? xcd * (q + 1) : r * (q + 1) + (xcd - r) * q) + off; }
        const int nig = WGM * nN, gid = wgid / nig, fm = gid * WGM, gsz = (nM - fm) < WGM ? (nM - fm) : WGM;
        u.pm = fm + ((wgid % nig) % gsz); u.pn = (wgid % nig) / gsz; u.e = 0; u.li = 0; return true;
    }
};
struct MoeOrder {
    int NT, G, c; const PG8_LAS int* segt;
    __device__ bool next(int i, Unit& u) const {
        int mt, pn;
        if ((G & 7) == 0 && G == 256) { const int x = c & 7, j = c >> 3, per = 32 / NT; mt = (i * 8 + x) * per + j / NT; pn = j % NT; }
        else { const long L = (long)i * G + c; mt = (int)(L / NT); pn = (int)(L % NT); }
        if (mt >= segt[16]) return false;
        int e = 0;
#pragma unroll
        for (int k = 1; k < 16; ++k) e += (segt[k] <= mt) ? 1 : 0;
        u.pm = mt; u.pn = pn; u.e = e; u.li = i; return true;
    }
};

__device__ __forceinline__ unsigned cvt_pk_bf16(float lo, float hi) { unsigned r; asm volatile("v_cvt_pk_bf16_f32 %0, %1, %2" : "=v"(r) : "v"(lo), "v"(hi)); return r; }

typedef int i32x8 __attribute__((ext_vector_type(8)));
typedef i32x8 __attribute__((aligned(16))) i32x8a;
template <class Epi, class Sched, bool GATHER, bool F8 = false>
__device__ __forceinline__ void gemm_phase(PG8_LAS unsigned char* lds, const Gemm g, const Sched& S, const Epi& E, const PG8_LAS int* rowcache, int tid_in) {
    int tid_ = tid_in; asm volatile("" : "+v"(tid_));
    const int tid = tid_, wid = __builtin_amdgcn_readfirstlane(tid >> 6), lane = tid & 63, wr = wid >> 2, wc = wid & 3, fr = lane & 15, fq = lane >> 4;
    const int K = F8 ? g.K / 2 : g.K, nt = K / BK;
    unsigned voffB[2], vA[2][2], nvA[2][2]; int sR[2], sC[2];
    const size_t kstep = (size_t)(BK * 2);
    const size_t hstep = (size_t)HALF * K * 2;
    const size_t tstep = 2 * hstep;
    const size_t hstepB = Epi::WIDE ? (size_t)32 * K * 2 : hstep;
#pragma unroll
    for (int i = 0; i < 2; ++i) { int R, C; stage_rc(tid * 16 + i * 8192, R, C); const int R31 = Epi::PERM ? perm32(R & 31) : (R & 31);
        const int Rb = Epi::WIDE ? ((R >> 5) * 64 + R31) : ((R & ~31) + R31); sR[i] = R; sC[i] = C;
        voffB[i] = (unsigned)(Rb * K + C) * 2u;
        vA[0][i] = (unsigned)(R * K + C) * 2u; vA[1][i] = vA[0][i] + (unsigned)hstep; }
    const unsigned ldsw = (unsigned)wid * 1024u;
    const int aoff = lds_byte(wr * 64 + fr, fq * 8), boff = lds_byte(wc * 32 + fr, fq * 8);
    const int aoff8 = lds_byte(wr * 64 + fr, (fq >> 1) * 32 + (fq & 1) * 16), boff8 = lds_byte(wc * 32 + fr, (fq >> 1) * 32 + (fq & 1) * 16);
#define PG8_SA(b, h) (((b) * 2 + (h)) * HTB)
#define PG8_SB(b, h) ((4 + (b) * 2 + (h)) * HTB)
#define PG8_STAGE(bufoff, gbase, voff) do { _Pragma("unroll") for (int _i = 0; _i < 2; ++_i) \
        __builtin_amdgcn_global_load_lds((const unsigned*)((const char*)(gbase) + (voff)[_i]), (PG8_LAS unsigned*)(lds + (bufoff) + ldsw + _i * 8192), 16, 0, 0); } while (0)
#define PG8_LDA(dst, b, h) do { _Pragma("unroll") for (int m = 0; m < 4; ++m) _Pragma("unroll") for (int k = 0; k < 2; ++k) dst[m][k] = *(const PG8_LAS bf16x8*)(lds + PG8_SA(b, h) + aoff + m * 2048 + k * 1024); } while (0)
#define PG8_LDB(dst, b, h) do { _Pragma("unroll") for (int n = 0; n < 2; ++n) _Pragma("unroll") for (int k = 0; k < 2; ++k) dst[n][k] = *(const PG8_LAS bf16x8*)(lds + PG8_SB(b, h) + boff + n * 2048 + k * 1024); } while (0)
#define PG8_MMA(ai, bj, At, Bt) do { __builtin_amdgcn_s_setprio(1); _Pragma("unroll") for (int m = 0; m < 4; ++m) _Pragma("unroll") for (int n = 0; n < 2; ++n) _Pragma("unroll") for (int k = 0; k < 2; ++k) \
        acc[ai][bj][m][n] = __builtin_amdgcn_mfma_f32_16x16x32_bf16(Bt[n][k], At[m][k], acc[ai][bj][m][n], 0, 0, 0); __builtin_amdgcn_s_setprio(0); } while (0)
#define PG8_LDA8(dst, b, h) do { _Pragma("unroll") for (int m = 0; m < 4; ++m) dst[m] = *(const PG8_LAS i32x8a*)(lds + PG8_SA(b, h) + aoff8 + m * 2048); } while (0)
#define PG8_LDB8(dst, b, h) do { _Pragma("unroll") for (int n = 0; n < 2; ++n) dst[n] = *(const PG8_LAS i32x8a*)(lds + PG8_SB(b, h) + boff8 + n * 2048); } while (0)
#define PG8_MMA8(ai, bj, At, Bt) do { __builtin_amdgcn_s_setprio(1); _Pragma("unroll") for (int m = 0; m < 4; ++m) _Pragma("unroll") for (int n = 0; n < 2; ++n) \
        acc[ai][bj][m][n] = __builtin_amdgcn_mfma_scale_f32_16x16x128_f8f6f4(Bt[n], At[m], acc[ai][bj][m][n], 0, 0, 0, g.sb, 0, g.sa); \
        _Pragma("unroll") for (int m = 0; m < 4; ++m) asm volatile("" : "+v"(acc[ai][bj][m][0]), "+v"(acc[ai][bj][m][1])); __builtin_amdgcn_s_setprio(0); } while (0)
#define PG8_WAIT_V(n) asm volatile("s_waitcnt vmcnt(" #n ")" ::: "memory")
#define PG8_WAIT_L(n) asm volatile("s_waitcnt lgkmcnt(" #n ")" ::: "memory")
#define PG8_BAR __builtin_amdgcn_s_barrier()
#define PG8_SCHED __builtin_amdgcn_sched_barrier(0)
#define PG8_GATHER(dst, u) do { _Pragma("unroll") for (int _h = 0; _h < 2; ++_h) _Pragma("unroll") for (int _i = 0; _i < 2; ++_i) \
        dst[_h][_i] = (unsigned)(rowcache[(u).li * 256 + _h * 128 + sR[_i]] * K + sC[_i]) * 2u; } while (0)
    Unit cur, nxt; int ui = 0;
    if (!S.next(0, cur)) return;
    if constexpr (GATHER) { PG8_GATHER(vA, cur); }
#pragma unroll
    for (int h = 0; h < 2; ++h)
#pragma unroll
        for (int i = 0; i < 2; ++i) nvA[h][i] = vA[h][i];
    f32x4 acc[2][2][4][2];
#pragma unroll
    for (int a = 0; a < 2; ++a)
#pragma unroll
        for (int b = 0; b < 2; ++b)
#pragma unroll
            for (int m = 0; m < 4; ++m)
#pragma unroll
                for (int n = 0; n < 2; ++n) acc[a][b][m][n] = (f32x4){0.f, 0.f, 0.f, 0.f};
    bf16x8 At[4][2], B0[2][2], B1[2][2]; i32x8 At8[4], B08[2], B18[2];
    const char* cA = (const char*)g.A + (GATHER ? (size_t)0 : (size_t)cur.pm * tstep);
    const char* cB = (const char*)g.Bt + ((size_t)cur.e * g.N + (size_t)cur.pn * BM) * K * 2;
    PG8_STAGE(PG8_SB(0, 0), cB, voffB); PG8_STAGE(PG8_SB(0, 1), cB + hstepB, voffB); PG8_STAGE(PG8_SA(0, 0), cA, vA[0]); PG8_STAGE(PG8_SA(0, 1), cA, vA[1]);
    PG8_STAGE(PG8_SB(1, 0), cB + kstep, voffB); PG8_STAGE(PG8_SA(1, 0), cA + kstep, vA[0]); PG8_STAGE(PG8_SB(1, 1), cB + hstepB + kstep, voffB);
    PG8_WAIT_V(6); PG8_BAR;
    if (wr == 1) PG8_BAR;
    for (;;) {
        const bool has_next = S.next(ui + 1, nxt);
        const char* nA = has_next ? (const char*)g.A + (GATHER ? (size_t)0 : (size_t)nxt.pm * tstep) : cA;
        const char* nB = has_next ? (const char*)g.Bt + ((size_t)nxt.e * g.N + (size_t)nxt.pn * BM) * K * 2 : cB;
#pragma unroll 1
        for (int t = 0; t < nt; t += 2) {
            const bool last = (t == nt - 2);
            const char* a1 = cA + (size_t)(t + 1) * kstep;
            const char* a2 = last ? nA : cA + (size_t)(t + 2) * kstep; const char* b2 = last ? nB : cB + (size_t)(t + 2) * kstep;
            const char* a3 = a2 + kstep; const char* b3 = b2 + kstep;
            if constexpr (GATHER) { if (last && has_next) { PG8_GATHER(nvA, nxt); } }
            unsigned sA[2][2];
#pragma unroll
            for (int h = 0; h < 2; ++h)
#pragma unroll
                for (int i = 0; i < 2; ++i) sA[h][i] = (GATHER && last) ? nvA[h][i] : vA[h][i];
            if constexpr (!F8) {
            PG8_LDB(B0, 0, 0); PG8_LDB(B1, 0, 1); PG8_SCHED; PG8_LDA(At, 0, 0); PG8_STAGE(PG8_SA(1, 1), a1, vA[1]);
            PG8_WAIT_V(8); PG8_WAIT_L(0); PG8_BAR; PG8_MMA(0, 0, At, B0); PG8_MMA(0, 1, At, B1); PG8_BAR; PG8_SCHED;
            PG8_LDA(At, 0, 1); PG8_STAGE(PG8_SB(0, 0), b2, voffB); PG8_STAGE(PG8_SB(0, 1), b2 + hstepB, voffB); PG8_STAGE(PG8_SA(0, 0), a2, sA[0]);
            PG8_WAIT_V(8); PG8_WAIT_L(0); PG8_BAR; PG8_MMA(1, 0, At, B0); PG8_MMA(1, 1, At, B1); PG8_BAR; PG8_SCHED;
            PG8_LDB(B0, 1, 0); PG8_LDB(B1, 1, 1); PG8_SCHED; PG8_LDA(At, 1, 0); PG8_STAGE(PG8_SA(0, 1), a2, sA[1]);
            PG8_WAIT_V(8); PG8_WAIT_L(0); PG8_BAR; PG8_MMA(0, 0, At, B0); PG8_MMA(0, 1, At, B1); PG8_BAR; PG8_SCHED;
            PG8_LDA(At, 1, 1); PG8_STAGE(PG8_SB(1, 0), b3, voffB); PG8_STAGE(PG8_SB(1, 1), b3 + hstepB, voffB); PG8_STAGE(PG8_SA(1, 0), a3, sA[0]);
            PG8_WAIT_V(8); PG8_WAIT_L(0); PG8_BAR; PG8_MMA(1, 0, At, B0); PG8_MMA(1, 1, At, B1); PG8_BAR; PG8_SCHED;
            } else {
            PG8_LDB8(B08, 0, 0); PG8_LDB8(B18, 0, 1); PG8_SCHED; PG8_LDA8(At8, 0, 0); PG8_STAGE(PG8_SA(1, 1), a1, vA[1]);
            PG8_WAIT_V(8); PG8_WAIT_L(0); PG8_BAR; PG8_MMA8(0, 0, At8, B08); PG8_MMA8(0, 1, At8, B18); PG8_BAR; PG8_SCHED;
            PG8_LDA8(At8, 0, 1); PG8_STAGE(PG8_SB(0, 0), b2, voffB); PG8_STAGE(PG8_SB(0, 1), b2 + hstepB, voffB); PG8_STAGE(PG8_SA(0, 0), a2, sA[0]);
            PG8_WAIT_V(8); PG8_WAIT_L(0); PG8_BAR; PG8_MMA8(1, 0, At8, B08); PG8_MMA8(1, 1, At8, B18); PG8_BAR; PG8_SCHED;
            PG8_LDB8(B08, 1, 0); PG8_LDB8(B18, 1, 1); PG8_SCHED; PG8_LDA8(At8, 1, 0); PG8_STAGE(PG8_SA(0, 1), a2, sA[1]);
            PG8_WAIT_V(8); PG8_WAIT_L(0); PG8_BAR; PG8_MMA8(0, 0, At8, B08); PG8_MMA8(0, 1, At8, B18); PG8_BAR; PG8_SCHED;
            PG8_LDA8(At8, 1, 1); PG8_STAGE(PG8_SB(1, 0), b3, voffB); PG8_STAGE(PG8_SB(1, 1), b3 + hstepB, voffB); PG8_STAGE(PG8_SA(1, 0), a3, sA[0]);
            PG8_WAIT_V(8); PG8_WAIT_L(0); PG8_BAR; PG8_MMA8(1, 0, At8, B08); PG8_MMA8(1, 1, At8, B18); PG8_BAR; PG8_SCHED;
            }
        }
        if constexpr (F8) {
#pragma unroll
            for (int a = 0; a < 2; ++a)
#pragma unroll
                for (int b = 0; b < 2; ++b)
#pragma unroll
                    for (int m = 0; m < 4; ++m) asm volatile("" : "+v"(acc[a][b][m][0]), "+v"(acc[a][b][m][1])); }
        if (wr == 0) PG8_BAR;
        E(acc, cur, wr, wc, fr, fq);
        if (!has_next) break;
#pragma unroll
        for (int a = 0; a < 2; ++a)
#pragma unroll
            for (int b = 0; b < 2; ++b)
#pragma unroll
                for (int m = 0; m < 4; ++m)
#pragma unroll
                    for (int n = 0; n < 2; ++n) acc[a][b][m][n] = (f32x4){0.f, 0.f, 0.f, 0.f};
        cur = nxt; cA = nA; cB = nB; ++ui;
#pragma unroll
        for (int h = 0; h < 2; ++h)
#pragma unroll
            for (int i = 0; i < 2; ++i) vA[h][i] = nvA[h][i];
        if (wr == 1) PG8_BAR;
    }
    PG8_WAIT_V(0);
    PG8_BAR;
#undef PG8_SA
#undef PG8_SB
#undef PG8_STAGE
#undef PG8_LDA
#undef PG8_LDB
#undef PG8_MMA
#undef PG8_LDA8
#undef PG8_LDB8
#undef PG8_MMA8
#undef PG8_WAIT_V
#undef PG8_WAIT_L
#undef PG8_BAR
#undef PG8_SCHED
#undef PG8_GATHER
}
}

#define XB_TMO      128
#define XB_XCNT(j)  (256  + 64 * (j))
#define XB_XSUB(j)  (1280 + 64 * (j))
#define XB_XGEN(j)  (2304 + 64 * (j))
#define XB_TOP      3328
#define XB_TOPGEN   3392
#define XCD_BAR_WORDS 3456
#define XB_SPIN_CAP (1u << 18)
__device__ __forceinline__ unsigned xb_ld(unsigned* p)              { return __hip_atomic_load(p, __ATOMIC_RELAXED, __HIP_MEMORY_SCOPE_AGENT); }
__device__ __forceinline__ unsigned xb_add(unsigned* p, unsigned v) { return __hip_atomic_fetch_add(p, v, __ATOMIC_RELAXED, __HIP_MEMORY_SCOPE_AGENT); }
__device__ __forceinline__ unsigned xb_xcc_id() { return (unsigned)__builtin_amdgcn_s_getreg((3 << 11) | 20) & 0xFu; }
#define XB_SPIN(cond, bar) do { unsigned _sp = 0; while (cond) { __builtin_amdgcn_s_sleep(1); \
    if ((++_sp & 255u) == 0u) { if (xb_ld(&(bar)[XB_TMO])) break; if (_sp > XB_SPIN_CAP) { atomicAdd(&(bar)[XB_TMO], 1u); break; } } } } while (0)
struct XcdBarrier { unsigned* bar; unsigned x; volatile LAS unsigned* st; };
__device__ __forceinline__ XcdBarrier xcd_barrier_post(unsigned* bar, volatile LAS unsigned* st) {
    XcdBarrier b; b.bar = bar; b.x = xb_xcc_id(); b.st = st;
    if (threadIdx.x == 0) (void)xb_add(&bar[XB_XCNT(b.x)], 1u);
    return b;
}
__device__ __forceinline__ void xcd_barrier_complete(unsigned* bar, unsigned x, unsigned& nloc, unsigned& nx) {
    const unsigned G = gridDim.x * gridDim.y * gridDim.z;
    unsigned sum, cnt, mine, sp = 0u;
    for (;;) {
        sum = 0u; cnt = 0u; mine = 0u;
#pragma unroll
        for (unsigned j = 0; j < 16; ++j) { const unsigned c = xb_ld(&bar[XB_XCNT(j)]); sum += c; cnt += (c > 0u) ? 1u : 0u; mine = (j == x) ? c : mine; }
        if (sum == G) break;
        __builtin_amdgcn_s_sleep(1);
        if ((++sp & 255u) == 0u) { if (xb_ld(&bar[XB_TMO])) break; if (sp > XB_SPIN_CAP) { atomicAdd(&bar[XB_TMO], 1u); break; } }
    }
    nloc = mine > 0u ? mine : 1u; nx = cnt > 0u ? cnt : 1u;
}
__device__ __forceinline__ void xcd_barrier(const XcdBarrier& b, int tid) {
    asm volatile("s_waitcnt vmcnt(0)" ::: "memory");
    __syncthreads();
    if (tid == 0) {
        unsigned* bar = b.bar;
        __builtin_amdgcn_s_waitcnt(0);
        unsigned nloc = b.st[0], nx = b.st[1];
        if (nloc == 0u) { xcd_barrier_complete(bar, b.x, nloc, nx); b.st[0] = nloc; b.st[1] = nx; }
        const unsigned old = xb_add(&bar[XB_XSUB(b.x)], 1u);
        const unsigned gen = old / nloc;
        if (old + 1u == (gen + 1u) * nloc) {
            __builtin_amdgcn_fence(__ATOMIC_RELEASE, "agent");
            asm volatile("s_waitcnt vmcnt(0)" ::: "memory");
            const unsigned og = xb_add(&bar[XB_TOP], 1u);
            const unsigned tg = og / nx;
            if (og + 1u == (tg + 1u) * nx) xb_add(&bar[XB_TOPGEN], 1u);
            else XB_SPIN(xb_ld(&bar[XB_TOPGEN]) == tg, bar);
            __builtin_amdgcn_fence(__ATOMIC_ACQUIRE, "agent");
            xb_add(&bar[XB_XGEN(b.x)], 1u);
            asm volatile("s_waitcnt vmcnt(0)" ::: "memory");
        } else {
            XB_SPIN(xb_ld(&bar[XB_XGEN(b.x)]) == gen, bar);
            __builtin_amdgcn_fence(__ATOMIC_ACQUIRE, "agent");
            asm volatile("s_waitcnt vmcnt(0)" ::: "memory");
        }
    }
    __syncthreads();
}

struct Args { const GAS float* in[28]; GAS float* out; GAS unsigned char* ws; };
enum { I_X = 0, I_C, I_CTX, I_CCTX, I_ADAW, I_ADAB, I_N1G, I_N2G, I_FING, I_WIN, I_LRE, I_LIM, I_LDT, I_BRE, I_BIM, I_CRE, I_CIM, I_SD, I_WGLU, I_ALAM, I_SUBG, I_WAO, I_WO, I_RW, I_RB, I_W1, I_W3, I_W2 };

#define GIN(F_, i_) ((const float*)((F_).in[(i_)]))
struct Frame {
    LAS unsigned char* lds; volatile LAS unsigned* MISC;
    int tid, lane, wave, vcu, G;
    const GAS float* const* in; GAS float* out; GAS unsigned char* ws;
};

__device__ __forceinline__ void transpose_item(const float* W, int K, int N, bf16* WT, int k0, int n0, int drow0, LAS float* scr, int lane, const float* rs = nullptr) {
    float v[32];
    const float* wp = W + (size_t)(k0 + (lane >> 5)) * N + n0 + (lane & 31);
#pragma unroll
    for (int i = 0; i < 32; ++i) v[i] = wp[(size_t)(2 * i) * N];
    if (rs) {
#pragma unroll
        for (int i = 0; i < 32; ++i) v[i] *= rs[(k0 + (lane >> 5) + 2 * i) & 127]; }
#pragma unroll
    for (int i = 0; i < 32; ++i) scr[(2 * i + (lane >> 5)) * 33 + (lane & 31)] = v[i];
    LDS_WAIT(); asm volatile("" ::: "memory");
    const int c = lane & 7;
#pragma unroll
    for (int j = 0; j < 4; ++j) { const int n = (lane >> 3) + 8 * j; const LAS float* s = scr + (8 * c) * 33 + n;
        u32x4 o; o.x = pk2(s[0 * 33], s[1 * 33]); o.y = pk2(s[2 * 33], s[3 * 33]); o.z = pk2(s[4 * 33], s[5 * 33]); o.w = pk2(s[6 * 33], s[7 * 33]);
        *(u32x4*)(WT + (size_t)(drow0 + n) * K + k0 + 8 * c) = o; }
    LDS_WAIT(); asm volatile("" ::: "memory");
}
__device__ __forceinline__ void transpose_item_f8(const float* W, int K, int N, unsigned char* WT, int k0, int n0, int drow0, LAS float* scr, int lane) {
    float v[32];
    const float* wp = W + (size_t)(k0 + (lane >> 5)) * N + n0 + (lane & 31);
#pragma unroll
    for (int i = 0; i < 32; ++i) v[i] = wp[(size_t)(2 * i) * N];
#pragma unroll
    for (int i = 0; i < 32; ++i) scr[(2 * i + (lane >> 5)) * 33 + (lane & 31)] = v[i] * F8_SW;
    LDS_WAIT(); asm volatile("" ::: "memory");
    const int c = lane & 7;
#pragma unroll
    for (int j = 0; j < 4; ++j) { const int n = (lane >> 3) + 8 * j; const LAS float* s = scr + (8 * c) * 33 + n;
        u32x2 o; o.x = pk4_fp8(s[0 * 33], s[1 * 33], s[2 * 33], s[3 * 33]); o.y = pk4_fp8(s[4 * 33], s[5 * 33], s[6 * 33], s[7 * 33]);
        *(u32x2*)(WT + (size_t)(drow0 + n) * K + k0 + 8 * c) = o; }
    LDS_WAIT(); asm volatile("" ::: "memory");
}
__device__ __forceinline__ int ileave128(int n0, int second) { return (n0 >> 7) * 256 + second * 128 + (n0 & 127); }
struct CvtItem { const GAS float* W; GAS unsigned char* WT; int K, N, k0, n0, drow0, kind; };
__device__ __forceinline__ CvtItem cvt_decode(Frame& F, int l, int it, GAS unsigned char* wsw) {
    constexpr int I_IN = 16 * 128, I_GLU = 8 * 64, I_AO = 8 * 32, I_O = 16 * 32, I_EX = 16 * 32;
    CvtItem c; int r = it;
    if (r < I_IN) { const int kb = r / 128, nb = r % 128; c.W = F.in[I_WIN] + (size_t)l * D * NCOL; c.WT = wsw + WS_WIN; c.K = D; c.N = NCOL; c.k0 = 64 * kb; c.n0 = 32 * nb; c.drow0 = 32 * nb; c.kind = 1; return c; } r -= I_IN;
    if (r < I_GLU) { const int kb = r / 64, nb = r % 64, n0 = 32 * nb; c.W = F.in[I_WGLU] + (size_t)l * 512 * 2048; c.WT = wsw + WS_WGLU; c.K = 512; c.N = 2048; c.k0 = 64 * kb; c.n0 = n0;
        c.drow0 = n0 < 1024 ? ileave128(n0, 0) : ileave128(n0 - 1024, 1); c.kind = 1; return c; } r -= I_GLU;
    if (r < I_AO) { const int kb = r / 32, nb = r % 32; c.W = F.in[I_WAO] + (size_t)l * 512 * 1024; c.WT = wsw + WS_WAO; c.K = 512; c.N = 1024; c.k0 = 64 * kb; c.n0 = 32 * nb; c.drow0 = 32 * nb; c.kind = 1; return c; } r -= I_AO;
    if (r < I_O) { const int kb = r / 32, nb = r % 32; c.W = F.in[I_WO] + (size_t)l * D * D; c.WT = wsw + WS_WO; c.K = D; c.N = D; c.k0 = 64 * kb; c.n0 = 32 * nb; c.drow0 = 32 * nb; c.kind = 1; return c; } r -= I_O;
    { const int e = r / (3 * I_EX), q = r % (3 * I_EX), which = q / I_EX, ii = q % I_EX, kb = ii / 32, nb = ii % 32, n0 = 32 * nb;
      const size_t woff = ((size_t)l * NE + e) * D * D;
      c.W = (which == 0 ? F.in[I_W1] : which == 1 ? F.in[I_W3] : F.in[I_W2]) + woff;
      c.WT = which == 2 ? wsw + WS_W2 + (size_t)e * D * D : wsw + WS_W13 + (size_t)e * 2048 * D;
      c.K = D; c.N = D; c.k0 = 64 * kb; c.n0 = n0; c.drow0 = which == 2 ? n0 : ileave128(n0, which); c.kind = 1; }
    return c;
}
__device__ __forceinline__ void cvt_load(const CvtItem& c, float (&v)[32], int lane) {
    const GAS float* wp = c.W + (size_t)(c.k0 + (lane >> 5)) * c.N + c.n0 + (lane & 31);
#pragma unroll
    for (int i = 0; i < 32; ++i) v[i] = wp[(size_t)(2 * i) * c.N];
}
__device__ __forceinline__ void cvt_store(const CvtItem& c, const float (&v)[32], LAS float* scr, int lane) {
    const float sc = c.kind ? F8_SW : 1.0f;
#pragma unroll
    for (int i = 0; i < 32; ++i) scr[(2 * i + (lane >> 5)) * 33 + (lane & 31)] = v[i] * sc;
    LDS_WAIT(); asm volatile("" ::: "memory");
    const int cc = lane & 7;
    if (c.kind) {
#pragma unroll
        for (int j = 0; j < 4; ++j) { const int n = (lane >> 3) + 8 * j; const LAS float* s = scr + (8 * cc) * 33 + n;
            u32x2 o; o.x = pk4_fp8(s[0 * 33], s[1 * 33], s[2 * 33], s[3 * 33]); o.y = pk4_fp8(s[4 * 33], s[5 * 33], s[6 * 33], s[7 * 33]);
            *(GAS u32x2*)(c.WT + (size_t)(c.drow0 + n) * c.K + c.k0 + 8 * cc) = o; }
    } else {
#pragma unroll
        for (int j = 0; j < 4; ++j) { const int n = (lane >> 3) + 8 * j; const LAS float* s = scr + (8 * cc) * 33 + n;
            u32x4 o; o.x = pk2(s[0 * 33], s[1 * 33]); o.y = pk2(s[2 * 33], s[3 * 33]); o.z = pk2(s[4 * 33], s[5 * 33]); o.w = pk2(s[6 * 33], s[7 * 33]);
            *(GAS u32x4*)(c.WT + ((size_t)(c.drow0 + n) * c.K + c.k0 + 8 * cc) * 2) = o; }
    }
    LDS_WAIT(); asm volatile("" ::: "memory");
}
__device__ __forceinline__ void convert_weights(Frame& F, int l, int widx, int nw, LAS float* scr) {
    const int gw = F.vcu * nw + widx, NGW = F.G * nw;
    GAS unsigned char* const wsw = F.ws + ((l & 1) ? WS_WALT : 0);
    constexpr int NITEMS = 16 * 128 + 8 * 64 + 8 * 32 + 16 * 32 + NE * 3 * 16 * 32;
#pragma unroll 1
    for (int it = gw; it < NITEMS; it += 2 * NGW) {
        const bool two = it + NGW < NITEMS;
        const CvtItem a = cvt_decode(F, l, it, wsw), b = cvt_decode(F, l, two ? it + NGW : it, wsw);
        float va[32], vb[32];
        cvt_load(a, va, F.lane); cvt_load(b, vb, F.lane);
        cvt_store(a, va, scr, F.lane);
        if (two) cvt_store(b, vb, scr, F.lane);
    }
}

__device__ __forceinline__ void p0_mods(Frame& F) {
    LAS float* sc = (LAS float*)F.lds;
    LAS float* red = (LAS float*)(F.lds + 17 * 1024 * 4);
    const float* c = GIN(F, I_C); const float* cc = GIN(F, I_CCTX);
    for (int i = F.tid; i < 17 * 1024; i += NTHREADS) { const float v = i < 16 * 1024 ? c[i] : cc[i - 16 * 1024]; sc[i] = v / (1.0f + __expf(-v)); }
    __syncthreads();
    float* mods = (float*)(F.ws + WS_MODS);
    for (int item = blockIdx.x; item < DEPTH * 96; item += F.G) {
        const int l = item / 96, jc = item % 96;
        const float* W = GIN(F, I_ADAW) + (size_t)l * D * 6144 + jc * 64 + F.lane;
        float acc[17];
#pragma unroll
        for (int r = 0; r < 17; ++r) acc[r] = 0.f;
        const int kb = F.wave * 128;
#pragma unroll 4
        for (int k = 0; k < 128; ++k) { const float w = W[(size_t)(kb + k) * 6144];
#pragma unroll
            for (int r = 0; r < 17; ++r) acc[r] += sc[r * 1024 + kb + k] * w; }
#pragma unroll
        for (int r = 0; r < 17; ++r) red[(F.wave * 17 + r) * 64 + F.lane] = acc[r];
        __syncthreads();
        for (int o = F.tid; o < 17 * 64; o += NTHREADS) { const int r = o / 64, j = o % 64; float s = 0.f;
#pragma unroll
            for (int w = 0; w < 8; ++w) s += red[(w * 17 + r) * 64 + j];
            mods[((size_t)l * 17 + r) * 6144 + jc * 64 + j] = s + GIN(F, I_ADAB)[l * 6144 + jc * 64 + j]; }
        __syncthreads();
    }
    if (blockIdx.x == 0) { f32x2* rope = (f32x2*)(F.ws + WS_ROPE);
        for (int i = F.tid; i < 64 * 16; i += NTHREADS) { const int pos = i / 16, f = i % 16; const float inv = powf(10000.0f, -(float)f / 16.0f); const float ang = (float)pos * inv;
            rope[i] = (f32x2){cosf(ang), sinf(ang)}; } }
}

__device__ __forceinline__ void load_segt(Frame& F, int lc) {
    const unsigned* cnt = (const unsigned*)(F.ws + WS_CTL) + CW_CNT + lc * 64;
    if (F.tid < 16) F.MISC[96 + F.tid] = __hip_atomic_load(cnt + F.tid, __ATOMIC_RELAXED, __HIP_MEMORY_SCOPE_AGENT);
    __syncthreads();
    if (F.tid < 17) { int s = 0;
#pragma unroll
        for (int e = 0; e < 16; ++e) { const int t = ((int)F.MISC[96 + e] + 255) >> 8; s += e < F.tid ? t : 0; }
        F.MISC[32 + F.tid] = (unsigned)s; }
    __syncthreads();
}

struct Row { f32x4 v[4]; };
__device__ __forceinline__ void row_load(Row& r, const float* p, int lane) { const f32x4* q = (const f32x4*)p + lane;
#pragma unroll
    for (int j = 0; j < 4; ++j) r.v[j] = q[64 * j]; }
__device__ __forceinline__ void row_load_bf16(Row& r, const bf16* p, int lane) { const u32x2* q = (const u32x2*)p + lane;
#pragma unroll
    for (int j = 0; j < 4; ++j) { const u32x2 w = q[64 * j]; r.v[j] = (f32x4){bflo(w.x), bfhi(w.x), bflo(w.y), bfhi(w.y)}; } }
__device__ __forceinline__ void row_store(const Row& r, float* p, int lane) { f32x4* q = (f32x4*)p + lane;
#pragma unroll
    for (int j = 0; j < 4; ++j) q[64 * j] = r.v[j]; }
__device__ __forceinline__ float row_rms_scale(const Row& r, float eps) { float s = 0.f;
#pragma unroll
    for (int j = 0; j < 4; ++j) s += (r.v[j].x * r.v[j].x + r.v[j].y * r.v[j].y) + (r.v[j].z * r.v[j].z + r.v[j].w * r.v[j].w);
    return rsqrtf(wave_sum(s) * (1.0f / D) + eps); }
__device__ __forceinline__ void row_add_moe(Frame& F, Row& r, int row, const f32x4 (&g2c)[4], int lane) {
    const unsigned* ti = (const unsigned*)(F.ws + WS_TOKINFO) + 2 * row; const float* tw = (const float*)(F.ws + WS_TOKW) + 2 * row;
    const unsigned i0 = ti[0], i1 = ti[1]; const float w0 = tw[0], w1 = tw[1];
    const size_t s0 = (size_t)F.MISC[32 + (i0 >> 24)] * 256 + (i0 & 0xffffffu), s1 = (size_t)F.MISC[32 + (i1 >> 24)] * 256 + (i1 & 0xffffffu);
    const unsigned* y0 = (const unsigned*)((const unsigned char*)(F.ws + WS_YS) + s0 * D) + lane; const unsigned* y1 = (const unsigned*)((const unsigned char*)(F.ws + WS_YS) + s1 * D) + lane;
    const float v0 = w0 * (1.0f / F8_SY), v1 = w1 * (1.0f / F8_SY);
#pragma unroll
    for (int j = 0; j < 4; ++j) { const unsigned a = y0[64 * j], b = y1[64 * j]; const f32x4 g = g2c[j];
        const f32x2 a01 = __builtin_amdgcn_cvt_pk_f32_fp8((int)a, false), a23 = __builtin_amdgcn_cvt_pk_f32_fp8((int)a, true);
        const f32x2 b01 = __builtin_amdgcn_cvt_pk_f32_fp8((int)b, false), b23 = __builtin_amdgcn_cvt_pk_f32_fp8((int)b, true);
        r.v[j].x += g.x * (v0 * a01.x + v1 * b01.x); r.v[j].y += g.y * (v0 * a01.y + v1 * b01.y);
        r.v[j].z += g.z * (v0 * a23.x + v1 * b23.x); r.v[j].w += g.w * (v0 * a23.y + v1 * b23.y); }
}
__device__ __forceinline__ void row_add_moe2(Frame& F, Row& ra, Row& rb, int rowa, int rowb, const f32x4 (&g2c)[4], int lane) {
    const unsigned* tia = (const unsigned*)(F.ws + WS_TOKINFO) + 2 * rowa; const float* twa = (const float*)(F.ws + WS_TOKW) + 2 * rowa;
    const unsigned* tib = (const unsigned*)(F.ws + WS_TOKINFO) + 2 * rowb; const float* twb = (const float*)(F.ws + WS_TOKW) + 2 * rowb;
    const unsigned a0i = tia[0], a1i = tia[1], b0i = tib[0], b1i = tib[1]; const float wa0 = twa[0], wa1 = twa[1], wb0 = twb[0], wb1 = twb[1];
    const size_t sa0 = (size_t)F.MISC[32 + (a0i >> 24)] * 256 + (a0i & 0xffffffu), sa1 = (size_t)F.MISC[32 + (a1i >> 24)] * 256 + (a1i & 0xffffffu);
    const size_t sb0 = (size_t)F.MISC[32 + (b0i >> 24)] * 256 + (b0i & 0xffffffu), sb1 = (size_t)F.MISC[32 + (b1i >> 24)] * 256 + (b1i & 0xffffffu);
    const unsigned char* ys = (const unsigned char*)(F.ws + WS_YS);
    const unsigned* ya0 = (const unsigned*)(ys + sa0 * D) + lane; const unsigned* ya1 = (const unsigned*)(ys + sa1 * D) + lane;
    const unsigned* yb0 = (const unsigned*)(ys + sb0 * D) + lane; const unsigned* yb1 = (const unsigned*)(ys + sb1 * D) + lane;
    unsigned qa0[4], qa1[4], qb0[4], qb1[4];
#pragma unroll
    for (int j = 0; j < 4; ++j) { qa0[j] = ya0[64 * j]; qa1[j] = ya1[64 * j]; qb0[j] = yb0[64 * j]; qb1[j] = yb1[64 * j]; }
    const float va0 = wa0 * (1.0f / F8_SY), va1 = wa1 * (1.0f / F8_SY), vb0 = wb0 * (1.0f / F8_SY), vb1 = wb1 * (1.0f / F8_SY);
#pragma unroll
    for (int j = 0; j < 4; ++j) { const f32x4 g = g2c[j];
        { const unsigned a = qa0[j], b = qa1[j];
          const f32x2 a01 = __builtin_amdgcn_cvt_pk_f32_fp8((int)a, false), a23 = __builtin_amdgcn_cvt_pk_f32_fp8((int)a, true), b01 = __builtin_amdgcn_cvt_pk_f32_fp8((int)b, false), b23 = __builtin_amdgcn_cvt_pk_f32_fp8((int)b, true);
          ra.v[j].x += g.x * (va0 * a01.x + va1 * b01.x); ra.v[j].y += g.y * (va0 * a01.y + va1 * b01.y); ra.v[j].z += g.z * (va0 * a23.x + va1 * b23.x); ra.v[j].w += g.w * (va0 * a23.y + va1 * b23.y); }
        { const unsigned a = qb0[j], b = qb1[j];
          const f32x2 a01 = __builtin_amdgcn_cvt_pk_f32_fp8((int)a, false), a23 = __builtin_amdgcn_cvt_pk_f32_fp8((int)a, true), b01 = __builtin_amdgcn_cvt_pk_f32_fp8((int)b, false), b23 = __builtin_amdgcn_cvt_pk_f32_fp8((int)b, true);
          rb.v[j].x += g.x * (vb0 * a01.x + vb1 * b01.x); rb.v[j].y += g.y * (vb0 * a01.y + vb1 * b01.y); rb.v[j].z += g.z * (vb0 * a23.x + vb1 * b23.x); rb.v[j].w += g.w * (vb0 * a23.y + vb1 * b23.y); } }
}
__device__ __forceinline__ void row_modulate(Row& r, float rs, const float* gn, const float* sc, const float* sh, int lane) {
    const f32x4* a = (const f32x4*)gn + lane; const f32x4* b = (const f32x4*)sc + lane; const f32x4* c = (const f32x4*)sh + lane;
#pragma unroll
    for (int j = 0; j < 4; ++j) { const f32x4 g = a[64 * j], s = b[64 * j], h = c[64 * j]; r.v[j] = r.v[j] * rs * g * (1.0f + s) + h; }
}
struct ModTab { f32x4 gs[4], sh[4]; };
__device__ __forceinline__ void modtab_load(ModTab& t, const float* gn, const float* sc, const float* sh, int lane) {
    const f32x4* a = (const f32x4*)gn + lane; const f32x4* b = (const f32x4*)sc + lane; const f32x4* c = (const f32x4*)sh + lane;
#pragma unroll
    for (int j = 0; j < 4; ++j) { t.gs[j] = a[64 * j] * (1.0f + b[64 * j]); t.sh[j] = c[64 * j]; }
}
__device__ __forceinline__ void row_modulate_t(Row& r, float rs, const ModTab& t) {
#pragma unroll
    for (int j = 0; j < 4; ++j) r.v[j] = r.v[j] * rs * t.gs[j] + t.sh[j];
}
__device__ __forceinline__ void row_store_fp8(const Row& r, unsigned char* p, float s, int lane) { unsigned* q = (unsigned*)p + lane;
#pragma unroll
    for (int j = 0; j < 4; ++j) q[64 * j] = pk4_fp8(r.v[j].x * s, r.v[j].y * s, r.v[j].z * s, r.v[j].w * s); }
__device__ __forceinline__ void row_store_bf16(const Row& r, bf16* p, int lane) { u32x2* q = (u32x2*)p + lane;
#pragma unroll
    for (int j = 0; j < 4; ++j) q[64 * j] = (u32x2){pk2(r.v[j].x, r.v[j].y), pk2(r.v[j].z, r.v[j].w)}; }

__device__ __forceinline__ void phase_a(Frame& F, int l) {
    const int gw = F.vcu * NWAVES + F.wave, NGW = F.G * NWAVES;
    const float* mods = (const float*)(F.ws + WS_MODS);
    bf16* xres = (bf16*)(F.ws + WS_XRES); bf16* H = (bf16*)(F.ws + WS_H);
    const int per = (T + NGW - 1) / NGW, r0 = gw * per, r1 = r0 + per < T ? r0 + per : T;
    int mr_c = -1; ModTab mt; f32x4 g2c[4];
#pragma unroll
    for (int j = 0; j < 4; ++j) { float z_ = 0.f; asm volatile("" : "+v"(z_)); mt.gs[j] = (f32x4){z_, z_, z_, z_}; mt.sh[j] = mt.gs[j]; g2c[j] = mt.gs[j]; }
#pragma unroll 1
    for (int row = r0; row < r1; row += 2) {
        const int rowb = row + 1 < r1 ? row + 1 : row;
        const int mr = row < TL ? (row >> 11) : 16, mrb = rowb < TL ? (rowb >> 11) : 16; Row r, rb;
        if (mr != mr_c) { mr_c = mr; const float* m = mods + ((size_t)l * 17 + mr) * 6144; modtab_load(mt, GIN(F, I_N1G) + l * D, m + 1024, m, F.lane);
            if (l > 0) { const f32x4* gq = (const f32x4*)(mods + ((size_t)(l - 1) * 17 + mr) * 6144 + 5 * 1024) + F.lane;
#pragma unroll
                for (int j = 0; j < 4; ++j) g2c[j] = gq[64 * j]; } }
        if (mrb != mr) {
            if (l == 0) row_load(r, row < TL ? GIN(F, I_X) + (size_t)row * D : GIN(F, I_CTX) + (size_t)(row - TL) * D, F.lane);
            else { row_load_bf16(r, xres + (size_t)row * D, F.lane); row_add_moe(F, r, row, g2c, F.lane); }
            row_store_bf16(r, xres + (size_t)row * D, F.lane);
            { const float rs = row_rms_scale(r, NORM_EPS); row_modulate_t(r, rs, mt); }
            row_store_fp8(r, (unsigned char*)H + (size_t)row * D, F8_SX, F.lane);
            mr_c = mrb; { const float* m = mods + ((size_t)l * 17 + mrb) * 6144; modtab_load(mt, GIN(F, I_N1G) + l * D, m + 1024, m, F.lane);
              if (l > 0) { const f32x4* gq = (const f32x4*)(mods + ((size_t)(l - 1) * 17 + mrb) * 6144 + 5 * 1024) + F.lane;
#pragma unroll
                for (int j = 0; j < 4; ++j) g2c[j] = gq[64 * j]; } }
            if (l == 0) row_load(rb, rowb < TL ? GIN(F, I_X) + (size_t)rowb * D : GIN(F, I_CTX) + (size_t)(rowb - TL) * D, F.lane);
            else { row_load_bf16(rb, xres + (size_t)rowb * D, F.lane); row_add_moe(F, rb, rowb, g2c, F.lane); }
            row_store_bf16(rb, xres + (size_t)rowb * D, F.lane);
            { const float rs = row_rms_scale(rb, NORM_EPS); row_modulate_t(rb, rs, mt); }
            row_store_fp8(rb, (unsigned char*)H + (size_t)rowb * D, F8_SX, F.lane);
            continue; }
        if (l == 0) { row_load(r, row < TL ? GIN(F, I_X) + (size_t)row * D : GIN(F, I_CTX) + (size_t)(row - TL) * D, F.lane);
                      row_load(rb, rowb < TL ? GIN(F, I_X) + (size_t)rowb * D : GIN(F, I_CTX) + (size_t)(rowb - TL) * D, F.lane); }
        else { row_load_bf16(r, xres + (size_t)row * D, F.lane); row_load_bf16(rb, xres + (size_t)rowb * D, F.lane);
               row_add_moe2(F, r, rb, row, rowb, g2c, F.lane); }
        row_store_bf16(r, xres + (size_t)row * D, F.lane); row_store_bf16(rb, xres + (size_t)rowb * D, F.lane);
        { const float rs = row_rms_scale(r, NORM_EPS); row_modulate_t(r, rs, mt); }
        { const float rs = row_rms_scale(rb, NORM_EPS); row_modulate_t(rb, rs, mt); }
        row_store_fp8(r, (unsigned char*)H + (size_t)row * D, F8_SX, F.lane); row_store_fp8(rb, (unsigned char*)H + (size_t)rowb * D, F8_SX, F.lane);
    }
}
__device__ __forceinline__ void phase_final(Frame& F) {
    const int gw = F.vcu * NWAVES + F.wave, NGW = F.G * NWAVES;
    const float* mods = (const float*)(F.ws + WS_MODS); const bf16* xres = (const bf16*)(F.ws + WS_XRES);
    const int per = (TL + NGW - 1) / NGW, r0 = gw * per, r1 = r0 + per < TL ? r0 + per : TL;
    f32x4 fg[4], g2c[4]; int mr_c = -1;
#pragma unroll
    for (int j = 0; j < 4; ++j) { float z_ = 0.f; asm volatile("" : "+v"(z_)); fg[j] = ((const f32x4*)GIN(F, I_FING) + F.lane)[64 * j]; g2c[j] = (f32x4){z_, z_, z_, z_}; }
#pragma unroll 1
    for (int row = r0; row < r1; ++row) {
        const int mr = row >> 11;
        if (mr != mr_c) { mr_c = mr; const f32x4* gq = (const f32x4*)(mods + ((size_t)(DEPTH - 1) * 17 + mr) * 6144 + 5 * 1024) + F.lane;
#pragma unroll
            for (int j = 0; j < 4; ++j) g2c[j] = gq[64 * j]; }
        Row r; row_load_bf16(r, xres + (size_t)row * D, F.lane);
        row_add_moe(F, r, row, g2c, F.lane);
        const float rs = row_rms_scale(r, NORM_EPS);
#pragma unroll
        for (int j = 0; j < 4; ++j) r.v[j] = r.v[j] * rs * fg[j];
        row_store(r, (float*)(F.out + (size_t)row * D), F.lane);
    }
}

__device__ __forceinline__ void phase_f(Frame& F, int l, int Tm) {
    const int gw = F.vcu * NWAVES + F.wave, NGW = F.G * NWAVES;
    LAS float* rwt = (LAS float*)F.lds;
    LAS unsigned* tab = (LAS unsigned*)(F.lds + RC_OFF);
    LAS float* LG = (LAS float*)(F.lds + RC_OFF + 2560);
    for (int i = F.tid; i < 16 * 1024; i += NTHREADS) rwt[(i & 15) * 1024 + (i >> 4)] = GIN(F, I_RW)[i];
    if (F.tid < 16) F.MISC[64 + F.tid] = 0u;
    __syncthreads();
    const float* mods = (const float*)(F.ws + WS_MODS);
    const bf16* xres = (const bf16*)(F.ws + WS_XRES); bf16* H = (bf16*)(F.ws + WS_H);
    const int ex_l = ((F.lane >> 5) & 1) * 8 + ((F.lane >> 4) & 1) * 4 + ((F.lane >> 3) & 1) * 2 + ((F.lane >> 2) & 1);
    const int per = (Tm + NGW - 1) / NGW, r0 = gw * per, nr = r0 >= Tm ? 0 : (Tm - r0 < per ? Tm - r0 : per);
    int mr_c = -1; ModTab mt;
#pragma unroll
    for (int j = 0; j < 4; ++j) { float z_ = 0.f; asm volatile("" : "+v"(z_)); mt.gs[j] = (f32x4){z_, z_, z_, z_}; mt.sh[j] = mt.gs[j]; }
#pragma unroll 1
    for (int k = 0; k < nr; k += 2) {
        const bool two = k + 1 < nr; const int rowa = r0 + k, rowb = two ? rowa + 1 : rowa;
        Row ra, rb2; row_load_bf16(ra, xres + (size_t)rowa * D, F.lane); row_load_bf16(rb2, xres + (size_t)rowb * D, F.lane);
        { const int mr = rowa < TL ? (rowa >> 11) : 16; const float rs = row_rms_scale(ra, NORM_EPS);
          if (mr != mr_c) { mr_c = mr; const float* m = mods + ((size_t)l * 17 + mr) * 6144; modtab_load(mt, GIN(F, I_N2G) + l * D, m + 4 * 1024, m + 3 * 1024, F.lane); }
          row_modulate_t(ra, rs, mt);
          row_store_fp8(ra, (unsigned char*)H + (size_t)rowa * D, F8_SX, F.lane); }
        { const int mr = rowb < TL ? (rowb >> 11) : 16; const float rs = row_rms_scale(rb2, NORM_EPS);
          if (mr != mr_c) { mr_c = mr; const float* m = mods + ((size_t)l * 17 + mr) * 6144; modtab_load(mt, GIN(F, I_N2G) + l * D, m + 4 * 1024, m + 3 * 1024, F.lane); }
          row_modulate_t(rb2, rs, mt);
          row_store_fp8(rb2, (unsigned char*)H + (size_t)rowb * D, F8_SX, F.lane); }
        float pa[16], pb[16];
#pragma unroll
        for (int e = 0; e < 16; ++e) { pa[e] = 0.f; pb[e] = 0.f; }
#pragma unroll
        for (int j = 0; j < 4; ++j)
#pragma unroll
            for (int eh = 0; eh < 2; ++eh) { f32x4 ww[8];
#pragma unroll
                for (int e = 0; e < 8; ++e) ww[e] = ((const LAS f32x4*)(rwt + (8 * eh + e) * 1024))[64 * j + F.lane];
#pragma unroll
                for (int e = 0; e < 8; ++e) {
                    pa[8 * eh + e] = fmaf(ra.v[j].w, ww[e].w, fmaf(ra.v[j].z, ww[e].z, fmaf(ra.v[j].y, ww[e].y, fmaf(ra.v[j].x, ww[e].x, pa[8 * eh + e]))));
                    pb[8 * eh + e] = fmaf(rb2.v[j].w, ww[e].w, fmaf(rb2.v[j].z, ww[e].z, fmaf(rb2.v[j].y, ww[e].y, fmaf(rb2.v[j].x, ww[e].x, pb[8 * eh + e])))); }
#pragma unroll
                for (int e = 0; e < 8; ++e) asm volatile("" : "+v"(pa[8 * eh + e]), "+v"(pb[8 * eh + e]));
            }
#pragma unroll
        for (int h2 = 0; h2 < 2; ++h2) {
            float p[16];
#pragma unroll
            for (int e = 0; e < 16; ++e) p[e] = h2 ? pb[e] : pa[e];
            float q8[8], q4[4], q2[2], q1;
            { const bool hi = (F.lane & 32) != 0;
#pragma unroll
              for (int e = 0; e < 8; ++e) { const float keep = hi ? p[e + 8] : p[e], send = hi ? p[e] : p[e + 8]; q8[e] = keep + other_half(send, hi); } }
            { const bool hi = (F.lane & 16) != 0;
#pragma unroll
              for (int e = 0; e < 4; ++e) { const float keep = hi ? q8[e + 4] : q8[e], send = hi ? q8[e] : q8[e + 4]; q4[e] = keep + xor_lane<16>(send); } }
            { const bool hi = (F.lane & 8) != 0;
#pragma unroll
              for (int e = 0; e < 2; ++e) { const float keep = hi ? q4[e + 2] : q4[e], send = hi ? q4[e] : q4[e + 2]; q2[e] = keep + xor_lane<8>(send); } }
            { const bool hi = (F.lane & 4) != 0; const float keep = hi ? q2[1] : q2[0], send = hi ? q2[0] : q2[1]; q1 = keep + xor_lane<4>(send); }
            q1 += xor_lane<2>(q1); q1 += xor_lane<1>(q1);
            if ((F.lane & 3) == 0 && (h2 == 0 || two)) LG[(F.wave * 20 + k + h2) * 16 + ex_l] = q1;
        }
    }
    LDS_WAIT();
    if (F.lane < nr) {
        float aff[16], sel[16];
#pragma unroll
        for (int e4 = 0; e4 < 4; ++e4) { const f32x4 lg = *(const LAS f32x4*)(LG + (F.wave * 20 + F.lane) * 16 + 4 * e4); const f32x4 rb = *(const f32x4*)(GIN(F, I_RB) + 4 * e4);
#pragma unroll
            for (int k = 0; k < 4; ++k) { aff[4 * e4 + k] = 1.0f / (1.0f + expf(-lg[k])); sel[4 * e4 + k] = aff[4 * e4 + k] + rb[k]; } }
        float gs4[4];
#pragma unroll
        for (int g = 0; g < 4; ++g) { const float a = sel[4 * g], b = sel[4 * g + 1], c = sel[4 * g + 2], d = sel[4 * g + 3];
            gs4[g] = fmaxf(fmaxf(fmaxf(a + b, a + c), fmaxf(a + d, b + c)), fmaxf(b + d, c + d)); }
        int gbest = 0; float gsb = gs4[0];
#pragma unroll
        for (int g = 1; g < 4; ++g) { const bool c = gs4[g] > gsb; gsb = c ? gs4[g] : gsb; gbest = c ? g : gbest; }
        float cs[4], ca[4];
#pragma unroll
        for (int k = 0; k < 4; ++k) { cs[k] = gbest == 0 ? sel[k] : (gbest == 1 ? sel[4 + k] : (gbest == 2 ? sel[8 + k] : sel[12 + k]));
                                      ca[k] = gbest == 0 ? aff[k] : (gbest == 1 ? aff[4 + k] : (gbest == 2 ? aff[8 + k] : aff[12 + k])); }
        int k0 = 0; float s0 = cs[0], a0 = ca[0];
#pragma unroll
        for (int k = 1; k < 4; ++k) { const bool c = cs[k] > s0; s0 = c ? cs[k] : s0; a0 = c ? ca[k] : a0; k0 = c ? k : k0; }
        float neg_ = -1e30f; asm volatile("" : "+v"(neg_));
        int k1 = -1; float s1 = neg_, a1 = 0.f;
#pragma unroll
        for (int k = 0; k < 4; ++k) { const bool c = (k != k0) && (k1 < 0 || cs[k] > s1); s1 = c ? cs[k] : s1; a1 = c ? ca[k] : a1; k1 = c ? k : k1; }
        const int e0 = 4 * gbest + k0, e1 = 4 * gbest + k1;
        const float wn = 1.0f / (a0 + a1);
        const unsigned p0 = atomicAdd((unsigned*)&F.MISC[64 + e0], 1u), p1 = atomicAdd((unsigned*)&F.MISC[64 + e1], 1u);
        LAS unsigned* t = tab + (F.wave * 20 + F.lane) * 4; t[0] = ((unsigned)e0 << 24) | p0; t[1] = ((unsigned)e1 << 24) | p1; t[2] = __builtin_bit_cast(unsigned, a0 * wn); t[3] = __builtin_bit_cast(unsigned, a1 * wn);
    }
    __syncthreads();
    unsigned* cnt = (unsigned*)(F.ws + WS_CTL) + CW_CNT + l * 64;
    if (F.tid < 16) { const unsigned n = F.MISC[64 + F.tid]; F.MISC[80 + F.tid] = n ? __hip_atomic_fetch_add(cnt + F.tid, n, __ATOMIC_RELAXED, __HIP_MEMORY_SCOPE_AGENT) : 0u; }
    __syncthreads();
    unsigned* ti = (unsigned*)(F.ws + WS_TOKINFO); float* tw = (float*)(F.ws + WS_TOKW); int* list = (int*)(F.ws + WS_LIST);
    if (F.lane < nr) { const int row = r0 + F.lane; const LAS unsigned* t = tab + (F.wave * 20 + F.lane) * 4;
#pragma unroll
        for (int k = 0; k < 2; ++k) { const unsigned e = t[k] >> 24, pos = (t[k] & 0xffffffu) + F.MISC[80 + e];
            ti[2 * row + k] = (e << 24) | pos; tw[2 * row + k] = __builtin_bit_cast(float, t[2 + k]); list[(size_t)e * T + pos] = row; } }
}

__device__ __forceinline__ void fill_rowcache(Frame& F, const pg8::MoeOrder& S) {
    LAS int* rc = (LAS int*)(F.lds + RC_OFF); const int* list = (const int*)(F.ws + WS_LIST);
    if (F.tid < 256) {
        pg8::Unit u; u.pm = 0; u.pn = 0; u.e = 0; u.li = 0; int v[16]; bool ok[16];
#pragma unroll
        for (int i = 0; i < 16; ++i) { const bool has = S.next(i, u); const int local = (u.pm - (int)F.MISC[32 + u.e]) * 256 + F.tid;
            const bool in = has && local < (int)F.MISC[96 + u.e]; v[i] = in ? list[(size_t)u.e * T + local] : 0; ok[i] = has; }
#pragma unroll
        for (int i = 0; i < 16; ++i) if (ok[i]) rc[i * 256 + F.tid] = v[i];
    }
    __syncthreads();
}

__device__ __forceinline__ unsigned pk4_u8(float a, float b, float c, float d) { unsigned r = 0u;
    r = __builtin_amdgcn_cvt_pk_u8_f32(a, 0, r); r = __builtin_amdgcn_cvt_pk_u8_f32(b, 1, r); r = __builtin_amdgcn_cvt_pk_u8_f32(c, 2, r); r = __builtin_amdgcn_cvt_pk_u8_f32(d, 3, r); return r; }
struct EpiProj {
    static constexpr bool PERM = false; static constexpr bool WIDE = true;
    bf16* P; const f32x2* rope;
    __device__ __forceinline__ void operator()(const f32x4 (&acc)[2][2][4][2], const pg8::Unit& u, int wr, int wc, int fr, int fq) const {
        const int type = u.pn < 2 ? 0 : (u.pn < 4 ? 1 : (u.pn < 6 ? 2 : (u.pn < 8 ? 0 : 3)));
        const bool dorope = (type == 1 || type == 2) && u.pm < TL / 256;
        if (type == 3) {
#pragma unroll
            for (int ai = 0; ai < 2; ++ai)
#pragma unroll
                for (int m = 0; m < 4; ++m) { const int row = u.pm * 256 + ai * 128 + wr * 64 + m * 16 + fr;
                    unsigned X[2][2];
#pragma unroll
                    for (int bj = 0; bj < 2; ++bj)
#pragma unroll
                        for (int n = 0; n < 2; ++n) { const f32x4 v = acc[ai][bj][m][n];
                            X[bj][n] = pk4_u8(sigmoidf_(v[0]) * 255.0f, sigmoidf_(v[1]) * 255.0f, sigmoidf_(v[2]) * 255.0f, sigmoidf_(v[3]) * 255.0f); }
                    const auto z0 = __builtin_amdgcn_permlane16_swap(X[0][0], X[0][1], false, false); const auto z1 = __builtin_amdgcn_permlane16_swap(X[1][0], X[1][1], false, false);
                    const auto w0 = __builtin_amdgcn_permlane32_swap(z0[0], z1[0], false, false); const auto w1 = __builtin_amdgcn_permlane32_swap(z0[1], z1[1], false, false);
                    *(u32x4*)((unsigned char*)P + (size_t)row * (NCOL * 2) + NCOL + (u.pn - 8) * 256 + wc * 64 + 16 * fq) = (u32x4){w0[0], w1[0], w0[1], w1[1]}; }
            return; }
        int fql = fq; asm volatile("" : "+v"(fql));
        f32x4 csA[2][2], csB[4][2];
#pragma unroll
        for (int ai = 0; ai < 2; ++ai) { csA[ai][0] = (f32x4){1.f, 0.f, 1.f, 0.f}; csA[ai][1] = csA[ai][0]; }
#pragma unroll
        for (int m = 0; m < 4; ++m) { csB[m][0] = (f32x4){1.f, 0.f, 1.f, 0.f}; csB[m][1] = csB[m][0]; }
        if (dorope) {
#pragma unroll
            for (int ai = 0; ai < 2; ++ai) { const int pos = ((u.pm * 256 + ai * 128 + wr * 64) & (SEQ - 1)) >> 6; const f32x4* rp = (const f32x4*)(rope + pos * 16 + 4 * fql); csA[ai][0] = rp[0]; csA[ai][1] = rp[1]; }
            int frl = fr; asm volatile("" : "+v"(frl));
#pragma unroll
            for (int m = 0; m < 4; ++m) { const int pos = 16 * m + frl; const f32x4* rp = (const f32x4*)(rope + pos * 16 + 4 * fql); csB[m][0] = rp[0]; csB[m][1] = rp[1]; }
#pragma unroll
            for (int ai = 0; ai < 2; ++ai)
#pragma unroll
                for (int k = 0; k < 2; ++k) asm volatile("" : "+v"(csA[ai][k].x), "+v"(csA[ai][k].y), "+v"(csA[ai][k].z), "+v"(csA[ai][k].w));
#pragma unroll
            for (int m = 0; m < 4; ++m)
#pragma unroll
                for (int k = 0; k < 2; ++k) asm volatile("" : "+v"(csB[m][k].x), "+v"(csB[m][k].y), "+v"(csB[m][k].z), "+v"(csB[m][k].w));
        }
#pragma unroll
        for (int ai = 0; ai < 2; ++ai)
#pragma unroll
            for (int m = 0; m < 4; ++m) { const int row = u.pm * 256 + ai * 128 + wr * 64 + m * 16 + fr;
                bf16* rowp = P + (size_t)row * NCOL + u.pn * 256 + wc * 64 + (fql & 1) * 16 + (fql >> 1) * 8;
#pragma unroll
                for (int bj = 0; bj < 2; ++bj) { f32x4 v0 = acc[ai][bj][m][0], v1 = acc[ai][bj][m][1];
                    if (type == 1 || type == 2) { const f32x4 cs0 = bj ? csB[m][0] : csA[ai][0], cs1 = bj ? csB[m][1] : csA[ai][1];
                        const float co[4] = {cs0.x, cs0.z, cs1.x, cs1.z}, si[4] = {cs0.y, cs0.w, cs1.y, cs1.w};
                        f32x4 o0, o1;
#pragma unroll
                        for (int j = 0; j < 4; ++j) { o0[j] = v0[j] * co[j] - v1[j] * si[j]; o1[j] = v1[j] * co[j] + v0[j] * si[j]; }
                        v0 = o0; v1 = o1; if (type == 1) { v0 = v0 * QSCALE; v1 = v1 * QSCALE; } }
                    const unsigned a0 = pk2(v0[0], v0[1]), a1 = pk2(v0[2], v0[3]), b0 = pk2(v1[0], v1[1]), b1 = pk2(v1[2], v1[3]);
                    const auto r0 = __builtin_amdgcn_permlane16_swap(a0, b0, false, false); const auto r1 = __builtin_amdgcn_permlane16_swap(a1, b1, false, false);
                    *(u32x4*)(rowp + bj * 32) = (u32x4){r0[0], r1[0], r0[1], r1[1]}; }
                asm volatile("" ::: "memory"); }
    }
};
struct EpiGlu {
    static constexpr bool PERM = true; static constexpr bool WIDE = false;
    const bf16* P; bf16* MG;
    __device__ __forceinline__ void operator()(const f32x4 (&acc)[2][2][4][2], const pg8::Unit& u, int wr, int wc, int fr, int fq) const {
        const int col = u.pn * 128 + wc * 32 + 8 * fq;
        u32x2 gs[2][4];
#pragma unroll
        for (int ai = 0; ai < 2; ++ai)
#pragma unroll
            for (int m = 0; m < 4; ++m) { const int row = u.pm * 256 + ai * 128 + wr * 64 + m * 16 + fr;
                gs[ai][m] = *(const u32x2*)((const unsigned char*)P + (size_t)row * (NCOL * 2) + NCOL + col); }
#pragma unroll
        for (int ai = 0; ai < 2; ++ai)
#pragma unroll
            for (int m = 0; m < 4; ++m) asm volatile("" : "+v"(gs[ai][m].x), "+v"(gs[ai][m].y));
#pragma unroll
        for (int ai = 0; ai < 2; ++ai)
#pragma unroll
            for (int m = 0; m < 4; ++m) { const int row = u.pm * 256 + ai * 128 + wr * 64 + m * 16 + fr; const u32x2 gq = gs[ai][m];
                const float g[8] = {u8f(gq.x, 0), u8f(gq.x, 1), u8f(gq.x, 2), u8f(gq.x, 3), u8f(gq.y, 0), u8f(gq.y, 1), u8f(gq.y, 2), u8f(gq.y, 3)};
                f32x2 rr[4];
#pragma unroll
                for (int n = 0; n < 2; ++n)
#pragma unroll
                    for (int jp = 0; jp < 2; ++jp) { const f32x2 a = {acc[ai][0][m][n][2 * jp], acc[ai][0][m][n][2 * jp + 1]};
                        const f32x2 s = {sigmoidf_(acc[ai][1][m][n][2 * jp]), sigmoidf_(acc[ai][1][m][n][2 * jp + 1])}; const f32x2 gg = {g[4 * n + 2 * jp] * F8_SH, g[4 * n + 2 * jp + 1] * F8_SH};
                        rr[2 * n + jp] = a * s * gg; }
                *(u32x2*)((unsigned char*)MG + (size_t)row * D + col) = (u32x2){pk4_fp8(rr[0].x, rr[0].y, rr[1].x, rr[1].y), pk4_fp8(rr[2].x, rr[2].y, rr[3].x, rr[3].y)}; }
    }
};
struct EpiMerge {
    static constexpr bool PERM = true; static constexpr bool WIDE = true;
    const bf16* P; const bf16* MG; unsigned char* MG8;
    __device__ __forceinline__ void operator()(const f32x4 (&acc)[2][2][4][2], const pg8::Unit& u, int wr, int wc, int fr, int fq) const {
        const int scol = u.pn * 256 + wc * 64 + ((fq & 1) ? 32 + 8 * (fq - 1) : 8 * fq);
        u32x4 pk[4];
#pragma unroll
        for (int ai = 0; ai < 2; ++ai) {
            u32x2 ga[4][2]; u32x2 old[4][2];
#pragma unroll
            for (int m = 0; m < 4; ++m) { const int row = u.pm * 256 + ai * 128 + wr * 64 + m * 16 + fr;
#pragma unroll
                for (int bj = 0; bj < 2; ++bj) { const int col = u.pn * 256 + wc * 64 + bj * 32 + 8 * fq;
                    ga[m][bj] = *(const u32x2*)((const unsigned char*)P + (size_t)row * (NCOL * 2) + NCOL + 1024 + col); old[m][bj] = *(const u32x2*)((const unsigned char*)MG + (size_t)row * D + col); } }
#pragma unroll
            for (int m = 0; m < 4; ++m)
#pragma unroll
                for (int bj = 0; bj < 2; ++bj) asm volatile("" : "+v"(ga[m][bj].x), "+v"(ga[m][bj].y), "+v"(old[m][bj].x), "+v"(old[m][bj].y));
            if (ai == 1) {
#pragma unroll
                for (int m = 0; m < 4; ++m) { const int row = u.pm * 256 + wr * 64 + m * 16 + fr; *(u32x4*)(MG8 + (size_t)row * D + scol) = pk[m]; } }
#pragma unroll
            for (int m = 0; m < 4; ++m) { const int row = u.pm * 256 + ai * 128 + wr * 64 + m * 16 + fr;
                unsigned w[2][2];
#pragma unroll
                for (int bj = 0; bj < 2; ++bj) { const u32x2 gq = ga[m][bj]; const u32x2 oq = old[m][bj];
                    const float g[8] = {u8f(gq.x, 0), u8f(gq.x, 1), u8f(gq.x, 2), u8f(gq.x, 3), u8f(gq.y, 0), u8f(gq.y, 1), u8f(gq.y, 2), u8f(gq.y, 3)};
                    const f32x2 q01 = __builtin_amdgcn_cvt_pk_f32_fp8((int)oq.x, false), q23 = __builtin_amdgcn_cvt_pk_f32_fp8((int)oq.x, true), q45 = __builtin_amdgcn_cvt_pk_f32_fp8((int)oq.y, false), q67 = __builtin_amdgcn_cvt_pk_f32_fp8((int)oq.y, true);
                    const float q[8] = {q01.x, q01.y, q23.x, q23.y, q45.x, q45.y, q67.x, q67.y};
                    float o[8];
#pragma unroll
                    for (int n = 0; n < 2; ++n)
#pragma unroll
                        for (int j = 0; j < 4; ++j) o[4 * n + j] = acc[ai][bj][m][n][j] * (g[4 * n + j] * F8_SH) + q[4 * n + j];
                    w[bj][0] = pk4_fp8(o[0], o[1], o[2], o[3]); w[bj][1] = pk4_fp8(o[4], o[5], o[6], o[7]); }
                const auto r0 = __builtin_amdgcn_permlane16_swap(w[0][0], w[1][0], false, false); const auto r1 = __builtin_amdgcn_permlane16_swap(w[0][1], w[1][1], false, false);
                const u32x4 r = (u32x4){r0[0], r1[0], r0[1], r1[1]};
                if (ai == 0) pk[m] = r; else *(u32x4*)(MG8 + (size_t)row * D + scol) = r; }
        }
    }
};
struct EpiRes {
    static constexpr bool PERM = true; static constexpr bool WIDE = false;
    bf16* X; const float* mods_l;
    __device__ __forceinline__ void operator()(const f32x4 (&acc)[2][2][4][2], const pg8::Unit& u, int wr, int wc, int fr, int fq) const {
        const int mr = u.pm < TL / 256 ? (u.pm >> 3) : 16; const float* g1 = mods_l + (size_t)mr * 6144 + 2 * 1024;
        const int col0 = u.pn * 256 + wc * 32 + 8 * fq;
        f32x4 gv[2][2];
#pragma unroll
        for (int bj = 0; bj < 2; ++bj)
#pragma unroll
            for (int n = 0; n < 2; ++n) gv[bj][n] = *(const f32x4*)(g1 + col0 + bj * 128 + n * 4);
        u32x4 pk[4][2];
#pragma unroll
        for (int ai = 0; ai < 2; ++ai) {
            u32x4 old[4][2];
#pragma unroll
            for (int m = 0; m < 4; ++m) { const int row = u.pm * 256 + ai * 128 + wr * 64 + m * 16 + fr; const bf16* rowp = X + (size_t)row * D + col0;
#pragma unroll
                for (int bj = 0; bj < 2; ++bj) old[m][bj] = *(const u32x4*)(rowp + bj * 128); }
#pragma unroll
            for (int m = 0; m < 4; ++m)
#pragma unroll
                for (int bj = 0; bj < 2; ++bj) asm volatile("" : "+v"(old[m][bj].x), "+v"(old[m][bj].y), "+v"(old[m][bj].z), "+v"(old[m][bj].w));
            if (ai == 1) {
#pragma unroll
                for (int m = 0; m < 4; ++m) { const int row = u.pm * 256 + wr * 64 + m * 16 + fr; bf16* rowp = X + (size_t)row * D + col0;
#pragma unroll
                    for (int bj = 0; bj < 2; ++bj) *(u32x4*)(rowp + bj * 128) = pk[m][bj]; } }
#pragma unroll
            for (int m = 0; m < 4; ++m) { const int row = u.pm * 256 + ai * 128 + wr * 64 + m * 16 + fr; bf16* rowp = X + (size_t)row * D + col0;
#pragma unroll
                for (int bj = 0; bj < 2; ++bj) { const u32x4 o = old[m][bj];
                    const f32x4 x0 = (f32x4){bflo(o.x), bfhi(o.x), bflo(o.y), bfhi(o.y)} + gv[bj][0] * acc[ai][bj][m][0];
                    const f32x4 x1 = (f32x4){bflo(o.z), bfhi(o.z), bflo(o.w), bfhi(o.w)} + gv[bj][1] * acc[ai][bj][m][1];
                    const u32x4 r = (u32x4){pk2(x0[0], x0[1]), pk2(x0[2], x0[3]), pk2(x1[0], x1[1]), pk2(x1[2], x1[3])};
                    if (ai == 0) pk[m][bj] = r; else *(u32x4*)(rowp + bj * 128) = r; } }
        }
    }
};
struct EpiSwiglu {
    static constexpr bool PERM = true; static constexpr bool WIDE = false;
    bf16* HID;
    __device__ __forceinline__ void operator()(const f32x4 (&acc)[2][2][4][2], const pg8::Unit& u, int wr, int wc, int fr, int fq) const {
#pragma unroll
        for (int ai = 0; ai < 2; ++ai)
#pragma unroll
            for (int m = 0; m < 4; ++m) { const size_t row = (size_t)u.pm * 256 + ai * 128 + wr * 64 + m * 16 + fr; const int col = u.pn * 128 + wc * 32 + 8 * fq;
                float o[8];
#pragma unroll
                for (int n = 0; n < 2; ++n)
#pragma unroll
                    for (int j = 0; j < 4; ++j) { const float a = acc[ai][0][m][n][j]; o[4 * n + j] = a * sigmoidf_(a) * acc[ai][1][m][n][j] * F8_SH; }
                *(u32x2*)((unsigned char*)HID + row * D + col) = (u32x2){pk4_fp8(o[0], o[1], o[2], o[3]), pk4_fp8(o[4], o[5], o[6], o[7])}; }
    }
};
struct EpiPlain {
    static constexpr bool PERM = true; static constexpr bool WIDE = true;
    unsigned char* O;
    __device__ __forceinline__ void operator()(const f32x4 (&acc)[2][2][4][2], const pg8::Unit& u, int wr, int wc, int fr, int fq) const {
        const int col = u.pn * 256 + wc * 64 + ((fq & 1) ? 32 + 8 * (fq - 1) : 8 * fq);
#pragma unroll
        for (int ai = 0; ai < 2; ++ai)
#pragma unroll
            for (int m = 0; m < 4; ++m) { const size_t row = (size_t)u.pm * 256 + ai * 128 + wr * 64 + m * 16 + fr;
                unsigned w[2][2];
#pragma unroll
                for (int bj = 0; bj < 2; ++bj)
#pragma unroll
                    for (int n = 0; n < 2; ++n) { const f32x4 v = acc[ai][bj][m][n]; w[bj][n] = pk4_fp8(v[0] * F8_SY, v[1] * F8_SY, v[2] * F8_SY, v[3] * F8_SY); }
                const auto r0 = __builtin_amdgcn_permlane16_swap(w[0][0], w[1][0], false, false); const auto r1 = __builtin_amdgcn_permlane16_swap(w[0][1], w[1][1], false, false);
                *(u32x4*)(O + row * D + col) = (u32x4){r0[0], r1[0], r0[1], r1[1]}; }
    }
};

constexpr int S5_HS = 136, S5_WAVE_BYTES = 2 * 32 * S5_HS * 2, S5_YL_OFF = 4 * S5_WAVE_BYTES, S5_YL_BYTES = 8192, S5_CONV_OFF = S5_YL_OFF + 4 * S5_YL_BYTES;
typedef float f32x16s __attribute__((ext_vector_type(16)));
__device__ __forceinline__ void s5_phase(Frame& F, int l) {
    if (F.wave >= 4) return;
    __builtin_amdgcn_s_setprio(2);
    const int lane = F.lane, fr = lane & 15, fq = lane >> 4, r = lane & 31, hh = lane >> 5;
    const int blk = F.vcu;
    const int dir = F.wave & 1, g = 2 * (blk & 15) + (F.wave >> 1), b = blk >> 4;
    LAS bf16* HH = (LAS bf16*)(F.lds + F.wave * S5_WAVE_BYTES);
    const size_t pbase = ((size_t)(l * 2 + dir) * NG + g) * 64;
    const float dt = expf(GIN(F, I_LDT)[(l * 2 + dir) * NG + g]);
    float are, aim;
    { const float lr = GIN(F, I_LRE)[pbase + lane], li = GIN(F, I_LIM)[pbase + lane]; const float dec = expf(lr * dt); are = dec * cosf(li * dt); aim = dec * sinf(li * dt); }
    bf16x8 Bop[4];
#pragma unroll
    for (int tl = 0; tl < 4; ++tl) { const int p = r + 32 * (tl & 1); const bool isim = tl >= 2;
        const float lr = GIN(F, I_LRE)[pbase + p], li = GIN(F, I_LIM)[pbase + p]; const float dec = expf(lr * dt); const float ar = dec * cosf(li * dt), ai = dec * sinf(li * dt);
        const float den = lr * lr + li * li, nr = ar - 1.0f, ni = ai; const float cr = (nr * lr + ni * li) / den, ci = (ni * lr - nr * li) / den;
        const float* br = GIN(F, I_BRE) + (pbase + p) * 16 + 8 * hh; const float* bi = GIN(F, I_BIM) + (pbase + p) * 16 + 8 * hh; bf16x8 v;
#pragma unroll
        for (int j = 0; j < 8; ++j) { const float x = isim ? (cr * bi[j] + ci * br[j]) : (cr * br[j] - ci * bi[j]); v[j] = (short)f2bf(x); }
        Bop[tl] = v; }
    bf16x8 Cop[4];
#pragma unroll
    for (int ks = 0; ks < 4; ++ks) { const size_t cb = (((size_t)(l * 2 + dir) * NG + g) * 16 + fr) * 64 + 16 * ks + 4 * fq; bf16x8 v;
#pragma unroll
        for (int j = 0; j < 8; ++j) v[j] = (short)f2bf((j & 1) ? -GIN(F, I_CIM)[cb + (j >> 1)] : GIN(F, I_CRE)[cb + (j >> 1)]);
        Cop[ks] = v; }
    const bf16* P = (const bf16*)(F.ws + WS_P); bf16* Y = (bf16*)(F.ws + (dir ? WS_YB : WS_YF));
    float hre = 0.f, him = 0.f;
#define S5_ROW0(tk) ((tk) < 8 ? TL + b * LC + (dir ? (LC - 32 * ((tk) + 1)) : 32 * (tk)) : b * SEQ + (dir ? (SEQ - 32 * ((tk) - 8 + 1)) : 32 * ((tk) - 8)))
    LAS bf16* YL = (LAS bf16*)(F.lds + S5_YL_OFF + F.wave * S5_YL_BYTES);
#define S5_READOUT(tkp) do { const LAS bf16* Hb = HH + ((tkp) & 1) * (32 * S5_HS); bf16x8 Hop[2][4]; \
        _Pragma("unroll") for (int st = 0; st < 2; ++st) _Pragma("unroll") for (int ks = 0; ks < 4; ++ks) Hop[st][ks] = *(const LAS bf16x8*)(Hb + (16 * st + fr) * S5_HS + 32 * ks + 8 * fq); \
        _Pragma("unroll") for (int st = 0; st < 2; ++st) { f32x4 a = {0.f, 0.f, 0.f, 0.f}; \
            _Pragma("unroll") for (int ks = 0; ks < 4; ++ks) a = __builtin_amdgcn_mfma_f32_16x16x32_bf16(Hop[st][ks], Cop[ks], a, 0, 0, 0); \
            _Pragma("unroll") for (int j = 0; j < 4; ++j) YL[(((tkp) & 7) * 32 + 16 * st + 4 * fq + j) * 16 + fr] = (bf16)f2bf(a[j]); } } while (0)
#define S5_FLUSH(g8) do { LDS_WAIT(); const int first = (g8) == 0 ? TL + b * LC + (dir ? LC - 1 : 0) : b * SEQ + (dir ? SEQ - 1 - 256 * ((g8) - 1) : 256 * ((g8) - 1)); \
        _Pragma("unroll") for (int it = 0; it < 8; ++it) { const int i = it * 32 + (lane >> 1); const u32x4 w = *(const LAS u32x4*)(YL + i * 16 + 8 * (lane & 1)); \
            *(u32x4*)(Y + (size_t)(dir ? first - i : first + i) * 512 + 16 * g + 8 * (lane & 1)) = w; } \
        LDS_WAIT(); } while (0)
    bf16x8 Ucur = *(const bf16x8*)(P + (size_t)(S5_ROW0(0) + (dir ? 31 - r : r)) * NCOL + CU_ + 16 * g + 8 * hh);
#pragma unroll 1
    for (int tk = 0; tk < 72; ++tk) {
        const int tkn = tk < 71 ? tk + 1 : 71;
        const bf16x8 Unext = *(const bf16x8*)(P + (size_t)(S5_ROW0(tkn) + (dir ? 31 - r : r)) * NCOL + CU_ + 16 * g + 8 * hh);
        f32x16s acc[4];
#pragma unroll
        for (int tl = 0; tl < 4; ++tl) {
#pragma unroll
            for (int i = 0; i < 16; ++i) acc[tl][i] = 0.f;
            acc[tl] = __builtin_amdgcn_mfma_f32_32x32x16_bf16(Ucur, Bop[tl], acc[tl], 0, 0, 0); }
        if (tk > 0) { S5_READOUT(tk - 1); if ((tk & 7) == 0) S5_FLUSH((tk >> 3) - 1); }
        float bre[32], bim[32];
#pragma unroll
        for (int i = 0; i < 16; ++i) { const int t0 = (i & 3) + 8 * (i >> 2);
            { const float xa = acc[0][i], xb = acc[1][i]; auto rr = __builtin_amdgcn_permlane32_swap(__float_as_uint(xa), __float_as_uint(xb), false, false);
              bre[t0] = __uint_as_float(rr[0]); bre[t0 + 4] = __uint_as_float(rr[1]); }
            { const float xa = acc[2][i], xb = acc[3][i]; auto rr = __builtin_amdgcn_permlane32_swap(__float_as_uint(xa), __float_as_uint(xb), false, false);
              bim[t0] = __uint_as_float(rr[0]); bim[t0 + 4] = __uint_as_float(rr[1]); } }
        LAS bf16* Hw = HH + (tk & 1) * (32 * S5_HS);
#pragma unroll
        for (int t = 0; t < 32; ++t) { const float nre = fmaf(-aim, him, fmaf(are, hre, bre[t])), nim = fmaf(aim, hre, fmaf(are, him, bim[t])); hre = nre; him = nim;
            *(LAS unsigned*)(Hw + t * S5_HS + 2 * lane) = pg8::cvt_pk_bf16(hre, him); }
        LDS_WAIT();
        Ucur = Unext;
    }
    S5_READOUT(71);
    S5_FLUSH(8);
    __builtin_amdgcn_s_setprio(0);
#undef S5_READOUT
#undef S5_FLUSH
#undef S5_ROW0
}
__device__ __forceinline__ float gelu_tanh(float x) { const float z = 0.7978845608028654f * (x + 0.044715f * x * x * x); const float e = __builtin_amdgcn_exp2f(2.8853900817779268f * z); const float th = 1.0f - 2.0f * __builtin_amdgcn_rcpf(e + 1.0f); return 0.5f * x * (1.0f + th); }
__device__ __forceinline__ void s5_finish(Frame& F, int l, bool ctx_rows) {
    const bf16* P = (const bf16*)(F.ws + WS_P); const bf16* YF = (const bf16*)(F.ws + WS_YF); const bf16* YB = (const bf16*)(F.ws + WS_YB); unsigned char* YG = (unsigned char*)(F.ws + WS_YG);
    const int blk = F.vcu, b = blk >> 4, c0 = 32 * (blk & 15);
    const float* dsk = GIN(F, I_SD) + l * 512;
    const int nrows = SEQ + (ctx_rows ? LC : 0);
    const int c16 = c0 + (F.tid & 1) * 16;
    f32x4 dd[4];
#pragma unroll
    for (int q = 0; q < 4; ++q) dd[q] = *(const f32x4*)(dsk + c16 + 4 * q);
#pragma unroll 1
    for (int rr = F.tid >> 1; rr < nrows; rr += NTHREADS / 2) { const size_t row = rr < SEQ ? (size_t)b * SEQ + rr : (size_t)TL + (size_t)b * LC + (rr - SEQ);
        u32x4 u[2], a[2], bb[2];
#pragma unroll
        for (int h = 0; h < 2; ++h) { u[h] = *(const u32x4*)(P + row * NCOL + CU_ + c16 + 8 * h); a[h] = *(const u32x4*)(YF + row * 512 + c16 + 8 * h); bb[h] = *(const u32x4*)(YB + row * 512 + c16 + 8 * h); }
        unsigned o[4];
#pragma unroll
        for (int h = 0; h < 2; ++h) { const f32x4 d0 = dd[2 * h], d1 = dd[2 * h + 1]; float y[8];
            y[0] = d0.x * bflo(u[h].x) + bflo(a[h].x) + bflo(bb[h].x); y[1] = d0.y * bfhi(u[h].x) + bfhi(a[h].x) + bfhi(bb[h].x);
            y[2] = d0.z * bflo(u[h].y) + bflo(a[h].y) + bflo(bb[h].y); y[3] = d0.w * bfhi(u[h].y) + bfhi(a[h].y) + bfhi(bb[h].y);
            y[4] = d1.x * bflo(u[h].z) + bflo(a[h].z) + bflo(bb[h].z); y[5] = d1.y * bfhi(u[h].z) + bfhi(a[h].z) + bfhi(bb[h].z);
            y[6] = d1.z * bflo(u[h].w) + bflo(a[h].w) + bflo(bb[h].w); y[7] = d1.w * bfhi(u[h].w) + bfhi(a[h].w) + bfhi(bb[h].w);
#pragma unroll
            for (int j = 0; j < 8; ++j) y[j] = gelu_tanh(y[j]) * F8_SH;
            o[2 * h] = pk4_fp8(y[0], y[1], y[2], y[3]); o[2 * h + 1] = pk4_fp8(y[4], y[5], y[6], y[7]); }
        *(u32x4*)(YG + row * 512 + c16) = (u32x4){o[0], o[1], o[2], o[3]}; }
}

typedef float f32x16 __attribute__((ext_vector_type(16)));
typedef short s16x4 __attribute__((ext_vector_type(4)));
constexpr int AT_BUF = 32768, AT_VOFF = 16384;
constexpr float AT_THR = 8.0f;
__device__ __forceinline__ unsigned cvtpk(float lo, float hi) { unsigned r; asm("v_cvt_pk_bf16_f32 %0, %1, %2" : "=v"(r) : "v"(lo), "v"(hi)); return r; }
template <int OFF> __device__ __forceinline__ s16x4 tr_read(unsigned a) { s16x4 r; asm volatile("ds_read_b64_tr_b16 %0, %1 offset:%2" : "=&v"(r) : "v"(a), "i"(OFF) : "memory"); return r; }
__device__ __forceinline__ void att_issue(const bf16* P, int krow, int h, LAS unsigned char* buf, int wave, int lane) {
#pragma unroll
    for (int j = 0; j < 2; ++j) { const int n = 2 * wave + j; const int img = n >> 3, rg = (n >> 1) & 3, cgp = n & 1;
        const int sub = lane >> 5, rr = (lane & 31) >> 2, pos = lane & 3; const int row = 8 * rg + rr, ch = 4 * (2 * cgp + sub) + (pos ^ ((row >> 2) & 3));
        const bf16* src = P + (size_t)(krow + 32 * img + row) * NCOL + h * 128 + 8 * ch;
        LAS unsigned char* dst = buf + 8192 * img + 2048 * rg + 1024 * cgp;
        __builtin_amdgcn_global_load_lds((const unsigned*)(src + CK), (LAS unsigned*)dst, 16, 0, 0);
        __builtin_amdgcn_global_load_lds((const unsigned*)(src + CV), (LAS unsigned*)(dst + AT_VOFF), 16, 0, 0); }
}
template <int ST, int S2> __device__ __forceinline__ void att_pv(f32x16 (&O)[2][4], unsigned va0, unsigned va1, const bf16x8 (&Pop)[2][2]) {
    constexpr int OFF = AT_VOFF + 8192 * ST + 4096 * S2;
    const s16x4 a0 = tr_read<OFF>(va0), b0 = tr_read<OFF>(va1), a1 = tr_read<OFF + 512>(va0), b1 = tr_read<OFF + 512>(va1);
    const s16x4 a2 = tr_read<OFF + 1024>(va0), b2 = tr_read<OFF + 1024>(va1), a3 = tr_read<OFF + 1536>(va0), b3 = tr_read<OFF + 1536>(va1);
    asm volatile("s_waitcnt lgkmcnt(0)" ::: "memory"); __builtin_amdgcn_sched_barrier(0);
#define AT_PK(L, H) (bf16x8){L[0], L[1], L[2], L[3], H[0], H[1], H[2], H[3]}
    const bf16x8 v0 = AT_PK(a0, b0), v1 = AT_PK(a1, b1), v2 = AT_PK(a2, b2), v3 = AT_PK(a3, b3);
#undef AT_PK
#pragma unroll
    for (int m = 0; m < 2; ++m) {
        O[m][0] = __builtin_amdgcn_mfma_f32_32x32x16_bf16(v0, Pop[m][S2], O[m][0], 0, 0, 0);
        O[m][1] = __builtin_amdgcn_mfma_f32_32x32x16_bf16(v1, Pop[m][S2], O[m][1], 0, 0, 0);
        O[m][2] = __builtin_amdgcn_mfma_f32_32x32x16_bf16(v2, Pop[m][S2], O[m][2], 0, 0, 0);
        O[m][3] = __builtin_amdgcn_mfma_f32_32x32x16_bf16(v3, Pop[m][S2], O[m][3], 0, 0, 0); }
}
template <int ST> __device__ __forceinline__ void att_sub(f32x16 (&O)[2][4], const bf16x8 (&Qop)[2][4], float (&mrun)[2], float (&lrun)[2], LAS unsigned char* kbuf, unsigned kb0, unsigned kb1, unsigned va0, unsigned va1, const bool SAFE) {
    bf16x8 Pop[2][2];
#pragma unroll
    for (int m = 0; m < 2; ++m) {
        f32x16 S;
#pragma unroll
        for (int i = 0; i < 16; ++i) S[i] = 0.f;
#pragma unroll
        for (int ks = 0; ks < 4; ++ks) { const int s = 4 * m + ks;
            const bf16x8 Kop = *(const LAS bf16x8*)(kbuf + 8192 * ST + ((s & 1) ? kb1 : kb0) + 512 * (s >> 1));
            S = __builtin_amdgcn_mfma_f32_32x32x16_bf16(Kop, Qop[m][ks], S, 0, 0, 0); }
        float rs = 0.f;
        if (SAFE) {
            float mx = S[0];
#pragma unroll
            for (int i = 1; i < 16; ++i) mx = fmaxf(mx, S[i]);
            { auto rr = __builtin_amdgcn_permlane32_swap(__float_as_uint(mx), __float_as_uint(mx), false, false); mx = fmaxf(__uint_as_float(rr[0]), __uint_as_float(rr[1])); }
            if (__any(mx > mrun[m] + AT_THR)) {
                const float mn = fmaxf(mrun[m], mx), alpha = __builtin_amdgcn_exp2f(mrun[m] - mn); mrun[m] = mn; lrun[m] *= alpha;
#pragma unroll
                for (int c = 0; c < 4; ++c) O[m][c] = O[m][c] * alpha; }
            const float mm = mrun[m];
#pragma unroll
            for (int i = 0; i < 16; ++i) { S[i] = __builtin_amdgcn_exp2f(S[i] - mm); rs += S[i]; }
        } else {
#pragma unroll
            for (int i = 0; i < 16; ++i) { S[i] = __builtin_amdgcn_exp2f(S[i]); rs += S[i]; }
        }
        lrun[m] += rs;
#pragma unroll
        for (int s2 = 0; s2 < 2; ++s2) { const u32x4 w = {cvtpk(S[8 * s2], S[8 * s2 + 1]), cvtpk(S[8 * s2 + 2], S[8 * s2 + 3]), cvtpk(S[8 * s2 + 4], S[8 * s2 + 5]), cvtpk(S[8 * s2 + 6], S[8 * s2 + 7])};
            Pop[m][s2] = __builtin_bit_cast(bf16x8, w); }
    }
    att_pv<ST, 0>(O, va0, va1, Pop);
    att_pv<ST, 1>(O, va0, va1, Pop);
}
__device__ __forceinline__ void att_loop(Frame& F, const bf16* P, int b, int h, int nkt, const bf16x8 (&Qop)[2][4], f32x16 (&O)[2][4], float (&lrun)[2], unsigned kb0, unsigned kb1, unsigned vb0, unsigned vb1, const bool SAFE) {
    const int lane = F.lane;
    __syncthreads();
    if (F.tid == 0 && !SAFE) F.MISC[120] = 0u;
    att_issue(P, TL + b * LC, h, F.lds, F.wave, lane);
    float zero_ = 0.f; asm volatile("" : "+v"(zero_));
#pragma unroll
    for (int m = 0; m < 2; ++m)
#pragma unroll
        for (int c = 0; c < 4; ++c)
#pragma unroll
            for (int i = 0; i < 16; ++i) O[m][c][i] = zero_;
    float neg_ = -1e30f; asm volatile("" : "+v"(neg_));
    float mrun[2] = {neg_, neg_}; lrun[0] = zero_; lrun[1] = zero_;
#pragma unroll 1
    for (int kt = 0; kt < nkt; ++kt) {
        asm volatile("s_waitcnt vmcnt(0)" ::: "memory");
        __syncthreads();
        if (kt + 1 < nkt) { const int k1 = kt + 1; const int krow = k1 < 4 ? TL + b * LC + 64 * k1 : b * SEQ + 64 * (k1 - 4);
            int lane_l = lane; asm volatile("" : "+v"(lane_l));
            att_issue(P, krow, h, F.lds + (k1 & 1) * AT_BUF, F.wave, lane_l); }
        LAS unsigned char* kbuf = F.lds + (kt & 1) * AT_BUF; const unsigned vo = (unsigned)(kt & 1) * AT_BUF;
        att_sub<0>(O, Qop, mrun, lrun, kbuf, kb0, kb1, vb0 + vo, vb1 + vo, SAFE);
        att_sub<1>(O, Qop, mrun, lrun, kbuf, kb0, kb1, vb0 + vo, vb1 + vo, SAFE);
    }
}
__device__ __forceinline__ void attn_unit(Frame& F, int l, int b, int h, int qt, bool isctx, float lam, float lam_init) {
    const int lane = F.lane, r = lane & 31, hh = lane >> 5;
    const bf16* P = (const bf16*)(F.ws + WS_P); bf16* ON = (bf16*)(F.ws + WS_ON);
    const int rowQ = (isctx ? TL + b * LC : b * SEQ + 256 * qt) + F.wave * 32 + r;
    const int nkt = isctx ? 4 : 36;
    const unsigned pr = (r & ~12u) | ((r & 4u) << 1) | ((r & 8u) >> 1);
    const unsigned kb0 = 2048u * (pr >> 3) + 64u * (pr & 7) + 16u * ((0u + hh) ^ ((pr >> 2) & 3)), kb1 = 2048u * (pr >> 3) + 64u * (pr & 7) + 16u * ((2u + hh) ^ ((pr >> 2) & 3));
    const unsigned q4 = (lane & 15) >> 2, p4 = lane & 3, blk = (lane >> 4) & 1;
    const unsigned ldsb = (unsigned)(size_t)F.lds;
    const unsigned vb0 = ldsb + 2048u * hh + 64u * (0u + q4) + 16u * ((2u * blk + (p4 >> 1)) ^ ((2u * hh + 0u) & 3)) + 8u * (p4 & 1);
    const unsigned vb1 = ldsb + 2048u * hh + 64u * (4u + q4) + 16u * ((2u * blk + (p4 >> 1)) ^ ((2u * hh + 1u) & 3)) + 8u * (p4 & 1);
    bf16x8 Qop[2][4];
#pragma unroll
    for (int m = 0; m < 2; ++m)
#pragma unroll
        for (int ks = 0; ks < 4; ++ks) Qop[m][ks] = *(const bf16x8*)(P + (size_t)rowQ * NCOL + CQ + h * 128 + m * 64 + 16 * ks + 8 * hh);
    f32x16 O[2][4]; float lrun[2];
    float l0, l1; bool safe = false;
#pragma unroll 1
    for (;;) {
        att_loop(F, P, b, h, nkt, Qop, O, lrun, kb0, kb1, vb0, vb1, safe);
        l0 = sum_xor32(lrun[0]); l1 = sum_xor32(lrun[1]);
        if (safe) break;
        const bool bad = !(l0 > 0x1p-100f && l0 < 0x1p100f && l1 > 0x1p-100f && l1 < 0x1p100f);
        if (__any(bad) && lane == 0) F.MISC[120] = 1u;
        __syncthreads();
        if (F.MISC[120] == 0u) break;
        safe = true; }
    const float c0 = 1.0f / l0, c1 = lam / l1; float ss = 0.f;
#pragma unroll
    for (int c = 0; c < 4; ++c)
#pragma unroll
        for (int i = 0; i < 16; ++i) { const float o = O[0][c][i] * c0 - O[1][c][i] * c1; O[0][c][i] = o; ss += o * o; }
    ss = sum_xor32(ss);
    const float rn = rsqrtf(ss * (1.0f / 128.0f) + SUBLN_EPS) * (1.0f - lam_init);
    const float* sg = GIN(F, I_SUBG) + l * 128; const float rn16 = rn * F8_SH;
    int l2 = lane; asm volatile("" : "+v"(l2));
    const int rowQo = (isctx ? TL + b * LC : b * SEQ + 256 * qt) + F.wave * 32 + (l2 & 31), hho = l2 >> 5;
    unsigned char* op = (unsigned char*)ON + (size_t)rowQo * 512 + h * 128 + 4 * hho;
#pragma unroll
    for (int c = 0; c < 4; ++c)
#pragma unroll
        for (int g4 = 0; g4 < 4; ++g4) { const f32x4 gg = *(const f32x4*)(sg + 32 * c + 8 * g4 + 4 * hho);
            *(unsigned*)(op + 32 * c + 8 * g4) = pk4_fp8(O[0][c][4 * g4] * rn16 * gg[0], O[0][c][4 * g4 + 1] * rn16 * gg[1], O[0][c][4 * g4 + 2] * rn16 * gg[2], O[0][c][4 * g4 + 3] * rn16 * gg[3]); }
}
__device__ __forceinline__ void attn_phase(Frame& F, int l, bool ctx_out) {
    const float lam_init = 0.8f - 0.6f * expf(-0.3f * (float)l);
    const float* al = GIN(F, I_ALAM) + l * 256;
    float d1 = 0.f, d2 = 0.f;
    for (int i = 0; i < 64; ++i) { d1 += al[i] * al[64 + i]; d2 += al[128 + i] * al[192 + i]; }
    const float lam = expf(d1) - expf(d2) + lam_init;
    const int nu = 512 + (ctx_out ? 64 : 0);
    for (int u = F.vcu; u < nu; u += F.G) {
        if (u < 512) { const int bh = u >> 3, qt = u & 7; attn_unit(F, l, bh >> 2, bh & 3, qt, false, lam, lam_init); }
        else { const int bh = u - 512; attn_unit(F, l, bh >> 2, bh & 3, 0, true, lam, lam_init); }
    }
    __syncthreads();
}

__global__ void __launch_bounds__(NTHREADS, 2) fwd_kernel(Args args) {
    extern __shared__ __attribute__((aligned(16))) unsigned char lds_raw[];
    Frame F;
    F.lds = (LAS unsigned char*)lds_raw; F.MISC = (volatile LAS unsigned*)(F.lds + MISC_OFF);
    F.tid = threadIdx.x; F.lane = F.tid & 63; F.wave = __builtin_amdgcn_readfirstlane(F.tid >> 6);
    F.G = gridDim.x; { const int bx = blockIdx.x; F.vcu = (F.G % 8 == 0) ? (bx % 8) * (F.G / 8) + bx / 8 : bx; }
    F.in = args.in; F.out = args.out; F.ws = args.ws;
    for (int u = F.tid; u < 256; u += NTHREADS) F.MISC[u] = 0u;
    __syncthreads();
    (void)xcd_barrier_post((unsigned*)(F.ws + WS_CTL) + CW_BAR, F.MISC + 8);
    const int wave0 = __builtin_amdgcn_readfirstlane(threadIdx.x >> 6);
#define RELAUNDER() do { unsigned z_ = 0u; asm volatile("" : "+v"(z_)); int l_ = (int)__builtin_amdgcn_mbcnt_hi(~0u, __builtin_amdgcn_mbcnt_lo(~0u, z_)); asm volatile("" : "+v"(l_)); int wv_ = wave0; asm volatile("" : "+s"(wv_)); F.lane = l_; F.wave = wv_; F.tid = wv_ * 64 + l_; \
    GAS unsigned char* w_ = args.ws; asm volatile("" : "+s"(w_)); F.ws = w_; } while (0)
#define GRID_BAR() do { RELAUNDER(); XcdBarrier b2_; GAS unsigned char* wb_ = args.ws; asm volatile("" : "+s"(wb_)); b2_.bar = (unsigned*)(wb_ + WS_CTL) + CW_BAR; unsigned x_ = xb_xcc_id(); asm volatile("" : "+s"(x_)); b2_.x = x_; b2_.st = F.MISC + 8; xcd_barrier(b2_, F.tid); } while (0)
    LAS unsigned char* lds = F.lds;
    const LAS int* rowcache = (const LAS int*)(lds + RC_OFF);
    const LAS int* segt = (const LAS int*)(lds + MISC_OFF + 32 * 4);
    const pg8::bf16_t* ws16 = (const pg8::bf16_t*)F.ws;

    p0_mods(F);
    __syncthreads();
    convert_weights(F, 0, F.wave, NWAVES, (LAS float*)(F.lds + F.wave * 16384));
    GRID_BAR();
#pragma unroll 1
    for (int l = 0; l < DEPTH; ++l) {
        const bool ctx_out = l < DEPTH - 1;
        const int Tm = ctx_out ? T : TL;
        const size_t wsel = (l & 1) ? WS_WALT : 0;
        RELAUNDER();
        if (l > 0) load_segt(F, l - 1);
        phase_a(F, l);
        GRID_BAR();
        RELAUNDER();
        { pg8::Gemm g{(const pg8::bf16_t*)(F.ws + WS_H), (const pg8::bf16_t*)(F.ws + wsel + WS_WIN), T, NCOL, D, F8_EX, F8_EW}; pg8::StaticOrder S; S.init(T, NCOL, F.G, (int)blockIdx.x);
          EpiProj E{(bf16*)(F.ws + WS_P), (const f32x2*)(F.ws + WS_ROPE)};
          pg8::gemm_phase<EpiProj, pg8::StaticOrder, false, true>(lds, g, S, E, rowcache, F.tid); }
        GRID_BAR();
        RELAUNDER();
        s5_phase(F, l);
        if (F.wave >= 4 && l + 1 < DEPTH) convert_weights(F, l + 1, F.wave - 4, 4, (LAS float*)(F.lds + S5_CONV_OFF + (F.wave - 4) * 8448));
        asm volatile("s_waitcnt vmcnt(0)" ::: "memory");
        __syncthreads();
        RELAUNDER();
        s5_finish(F, l, ctx_out);
        RELAUNDER();
        attn_phase(F, l, ctx_out);
        GRID_BAR();
        RELAUNDER();
        { pg8::Gemm g{(const pg8::bf16_t*)(F.ws + WS_YG), (const pg8::bf16_t*)(F.ws + wsel + WS_WGLU), Tm, 2048, 512, F8_EH, F8_EW}; pg8::StaticOrder S; S.init(Tm, 2048, F.G, (int)blockIdx.x);
          EpiGlu E{(const bf16*)(F.ws + WS_P), (bf16*)(F.ws + WS_MG)};
          pg8::gemm_phase<EpiGlu, pg8::StaticOrder, false, true>(lds, g, S, E, rowcache, F.tid); }
        GRID_BAR();
        RELAUNDER();
        { pg8::Gemm g{(const pg8::bf16_t*)(F.ws + WS_ON), (const pg8::bf16_t*)(F.ws + wsel + WS_WAO), Tm, 1024, 512, F8_EH, F8_EW}; pg8::StaticOrder S; S.init(Tm, 1024, F.G, (int)blockIdx.x);
          EpiMerge E{(const bf16*)(F.ws + WS_P), (const bf16*)(F.ws + WS_MG), (unsigned char*)(F.ws + WS_YF)};
          pg8::gemm_phase<EpiMerge, pg8::StaticOrder, false, true>(lds, g, S, E, rowcache, F.tid); }
        GRID_BAR();
        RELAUNDER();
        { pg8::Gemm g{(const pg8::bf16_t*)(F.ws + WS_YF), (const pg8::bf16_t*)(F.ws + wsel + WS_WO), Tm, 1024, 1024, F8_EH, F8_EW}; pg8::StaticOrder S; S.init(Tm, 1024, F.G, (int)blockIdx.x);
          EpiRes E{(bf16*)(F.ws + WS_XRES), (const float*)(F.ws + WS_MODS) + (size_t)l * 17 * 6144};
          pg8::gemm_phase<EpiRes, pg8::StaticOrder, false, true>(lds, g, S, E, rowcache, F.tid); }
        GRID_BAR();
        RELAUNDER();
        phase_f(F, l, Tm);
        GRID_BAR();
        RELAUNDER();
        load_segt(F, l);
        { pg8::MoeOrder S{8, F.G, (int)blockIdx.x, segt};
          fill_rowcache(F, S);
          pg8::Gemm g{(const pg8::bf16_t*)(F.ws + WS_H), (const pg8::bf16_t*)(F.ws + wsel + WS_W13), 0, 2048, 1024, F8_EX, F8_EW};
          EpiSwiglu E{(bf16*)(F.ws + WS_HID)};
          pg8::gemm_phase<EpiSwiglu, pg8::MoeOrder, true, true>(lds, g, S, E, rowcache, F.tid); }
        GRID_BAR();
        RELAUNDER();
        { pg8::MoeOrder S{4, F.G, (int)blockIdx.x, segt};
          pg8::Gemm g{(const pg8::bf16_t*)(F.ws + WS_HID), (const pg8::bf16_t*)(F.ws + wsel + WS_W2), 0, 1024, 1024, F8_EH, F8_EW};
          EpiPlain E{(unsigned char*)(F.ws + WS_YS)};
          pg8::gemm_phase<EpiPlain, pg8::MoeOrder, false, true>(lds, g, S, E, rowcache, F.tid); }
        GRID_BAR();
    }
    load_segt(F, DEPTH - 1);
    phase_final(F);
    (void)ws16;
}

extern "C" void kernel_launch(void* const* d_in, const int* in_sizes, int n_in, void* d_out, int out_size, void* d_ws, size_t ws_size, hipStream_t stream) {
    static int grid = 0;
    if (grid == 0) {
        if (n_in != 28 || ws_size < WS_END) { fprintf(stderr, "kernel_launch: n_in %d ws %zu (need %zu)\n", n_in, ws_size, (size_t)WS_END); grid = -1; return; }
        int dev = 0, cus = 0, per_cu = 0;
        if (hipGetDevice(&dev) != hipSuccess || hipDeviceGetAttribute(&cus, hipDeviceAttributeMultiprocessorCount, dev) != hipSuccess) { grid = -1; return; }
        if (hipFuncSetAttribute((const void*)fwd_kernel, hipFuncAttributeMaxDynamicSharedMemorySize, LDS_BYTES) != hipSuccess) { fprintf(stderr, "kernel_launch: hipFuncSetAttribute failed\n"); grid = -1; return; }
        if (hipOccupancyMaxActiveBlocksPerMultiprocessor(&per_cu, (const void*)fwd_kernel, NTHREADS, LDS_BYTES) != hipSuccess || per_cu < 1) { fprintf(stderr, "kernel_launch: occupancy query says %d\n", per_cu); }
        (void)hipGetLastError();
        grid = cus;
    }
    if (grid < 0) return;
    (void)hipMemsetAsync((char*)d_ws + WS_CTL, 0, CTL_ZERO_BYTES, stream);
    Args a{};
    for (int i = 0; i < 28; ++i) a.in[i] = (const GAS float*)d_in[i];
    a.out = (GAS float*)d_out; a.ws = (GAS unsigned char*)d_ws;
    hipLaunchKernelGGL(fwd_kernel, dim3(grid), dim3(NTHREADS), LDS_BYTES, stream, a);
    (void)in_sizes; (void)out_size;
}
```

```cpp
#include <hip/hip_runtime.h>
#include <cstdio>
#include <cstdint>

#define GAS __attribute__((address_space(1)))
#define LAS __attribute__((address_space(3)))
typedef unsigned short bf16;
typedef short bf16x8 __attribute__((ext_vector_type(8)));
typedef float f32x4 __attribute__((ext_vector_type(4)));
typedef float f32x2 __attribute__((ext_vector_type(2)));
typedef unsigned u32x4 __attribute__((ext_vector_type(4)));
typedef unsigned u32x2 __attribute__((ext_vector_type(2)));

constexpr int D = 1024, NB = 16, SEQ = 2048, LC = 256, DEPTH = 4;
constexpr int TL = NB * SEQ, TC = NB * LC, T = TL + TC;
constexpr int NCOL = 4096;
constexpr int CU_ = 0, CQ = 512, CK = 1024, CV = 1536, CGS = 2048, CGA = 3072;
constexpr int NG = 32, NE = 16;
constexpr float NORM_EPS = 1e-6f, SUBLN_EPS = 1e-5f;
constexpr float QSCALE = 0.125f * 1.4426950408889634f;
constexpr int NWAVES = 8, NTHREADS = 512;

constexpr size_t MiB = 1u << 20;
constexpr size_t WS_CTL = 0, CTL_ZERO_BYTES = 1 * MiB;
constexpr size_t WS_MODS = 1 * MiB;
constexpr size_t WS_ROPE = 3 * MiB;
constexpr size_t WS_TOKINFO = 4 * MiB;
constexpr size_t WS_TOKW = 4 * MiB + 512 * 1024;
constexpr size_t WS_LIST = 5 * MiB;
constexpr size_t WS_WIN = 8 * MiB, WS_WGLU = 16 * MiB, WS_WAO = 18 * MiB, WS_WO = 19 * MiB, WS_W13 = 24 * MiB, WS_W2 = 88 * MiB;
constexpr size_t WS_XRES = 120 * MiB;
constexpr size_t WS_S5C = 200 * MiB;
constexpr size_t S5C_BYTES = 512 + 4096 + 4096;
constexpr size_t WS_H = 264 * MiB;
constexpr size_t WS_P = 336 * MiB;
constexpr size_t WS_HID = 336 * MiB, WS_YS = 488 * MiB;
constexpr size_t WS_YG = 640 * MiB, WS_ON = 676 * MiB, WS_YF = 712 * MiB, WS_YB = 748 * MiB;
constexpr size_t WS_MG = 784 * MiB;
constexpr size_t WS_WALT = 848 * MiB;
constexpr size_t WS_END = 968 * MiB;
constexpr int CW_BAR = 4096;
constexpr int CW_CNT = 16384;

constexpr int RING_BYTES = 131072, RC_OFF = 131072, RC_BYTES = 16384, MISC_OFF = RC_OFF + RC_BYTES, LDS_BYTES = MISC_OFF + 1024;

__device__ __forceinline__ unsigned f2bf(float f) { unsigned u = __builtin_bit_cast(unsigned, f); return (u + 0x7fffu + ((u >> 16) & 1u)) >> 16; }
__device__ __forceinline__ unsigned pk2(float lo, float hi) { unsigned r; asm("v_cvt_pk_bf16_f32 %0, %1, %2" : "=v"(r) : "v"(lo), "v"(hi)); return r; }
__device__ __forceinline__ float bflo(unsigned w) { return __builtin_bit_cast(float, w << 16); }
__device__ __forceinline__ float bfhi(unsigned w) { return __builtin_bit_cast(float, w & 0xffff0000u); }
__device__ __forceinline__ float u8f(unsigned w, int b) { return (float)((w >> (8 * b)) & 0xffu) * (1.0f / 255.0f); }
__device__ __forceinline__ float bf2f(bf16 b) { return __builtin_bit_cast(float, ((unsigned)b) << 16); }
__device__ __forceinline__ float sigmoidf_(float x) { return __builtin_amdgcn_rcpf(1.0f + __builtin_amdgcn_exp2f(-1.4426950408889634f * x)); }
template <int O> __device__ __forceinline__ float xor_lane(float v) { const int iv = __float_as_int(v); return __int_as_float(__builtin_amdgcn_ds_swizzle(iv, (O << 10) | 0x1f)); }
__device__ __forceinline__ float sum_xor32(float v) { const auto rr = __builtin_amdgcn_permlane32_swap(__float_as_uint(v), __float_as_uint(v), false, false); return __uint_as_float(rr[0]) + __uint_as_float(rr[1]); }
__device__ __forceinline__ float other_half(float v, bool hi) { const auto rr = __builtin_amdgcn_permlane32_swap(__float_as_uint(v), __float_as_uint(v), false, false); return hi ? __uint_as_float(rr[0]) : __uint_as_float(rr[1]); }
__device__ __forceinline__ float wave_sum(float v) {
    v += xor_lane<1>(v); v += xor_lane<2>(v); v += xor_lane<4>(v); v += xor_lane<8>(v); v += xor_lane<16>(v);
    return sum_xor32(v);
}
__device__ __forceinline__ unsigned pk4_fp8(float a, float b, float c, float d) {
    a = __builtin_amdgcn_fmed3f(a, -448.f, 448.f); b = __builtin_amdgcn_fmed3f(b, -448.f, 448.f); c = __builtin_amdgcn_fmed3f(c, -448.f, 448.f); d = __builtin_amdgcn_fmed3f(d, -448.f, 448.f);
    int w = 0; w = __builtin_amdgcn_cvt_pk_fp8_f32(a, b, w, false); w = __builtin_amdgcn_cvt_pk_fp8_f32(c, d, w, true); return (unsigned)w; }
constexpr float F8_SY = 16.f;
constexpr float F8_SX = 8.f, F8_SH = 16.f, F8_SW = 64.f;
constexpr int F8_EX = 0x7c7c7c7c, F8_EH = 0x7b7b7b7b, F8_EW = 0x79797979;
#define LDS_WAIT() asm volatile("s_waitcnt lgkmcnt(0)" ::: "memory")
#define VM_WAIT() asm volatile("s_waitcnt vmcnt(0)" ::: "memory")

namespace pg8 {
#define PG8_LAS __attribute__((address_space(3)))
typedef unsigned short bf16_t;
constexpr int BM = 256, BK = 64, HALF = 128, HTB = HALF * BK * 2, STAGE_BYTES = 8 * HTB, NXCD = 8, WGM = 8;
__host__ __device__ __forceinline__ int lds_byte(int r, int c) { const int st = (r >> 4) * 2 + (c >> 5), rr = r & 15, cc = c & 31, ob = rr * 64 + cc * 2; return st * 1024 + (ob ^ (((ob >> 9) & 1) << 5)); }
__host__ __device__ __forceinline__ void stage_rc(int b, int& R, int& C) { const int st = b / 1024, sb = b % 1024, swz = sb ^ (((sb >> 9) & 1) << 5); R = (st >> 1) * 16 + swz / 64; C = (st & 1) * 32 + (swz % 64) / 2; }
__host__ __device__ __forceinline__ int perm32(int rho) { const int n = rho >> 4, i = rho & 15; return 8 * (i >> 2) + 4 * n + (i & 3); }

struct Unit { int pm, pn, e, li; };
struct Gemm { const bf16_t* A; const bf16_t* Bt; int M, N, K; int sa, sb; };

struct StaticOrder {
    int nM, nN, nwg, G, c;
    __device__ void init(int M, int N, int G_, int c_) { nM = M / BM; nN = N / BM; nwg = nM * nN; G = G_; c = c_; }
    __device__ bool next(int i, Unit& u) const {
        const long L = (long)i * G + c; if (L >= nwg) return false;
        int wgid = (int)L; { const int q = nwg / NXCD, r = nwg % NXCD, xcd = wgid % NXCD, off = wgid / NXCD; wgid = (xcd < r ? xcd * (q + 1) : r * (q + 1) + (xcd - r) * q) + off; }
        const int nig = WGM * nN, gid = wgid / nig, fm = gid * WGM, gsz = (nM - fm) < WGM ? (nM - fm) : WGM;
        u.pm = fm + ((wgid % nig) % gsz); u.pn = (wgid % nig) / gsz; u.e = 0; u.li = 0; return true;
    }
};
struct MoeOrder {
    int NT, G, c; const PG8_LAS int* segt;
    __device__ bool next(int i, Unit& u) const {
        int mt, pn;
        if ((G & 7) == 0 && G == 256) { const int x = c & 7, j = c >> 3, per = 32 / NT; mt = (i * 8 + x) * per + j / NT; pn = j % NT; }
        else { const long L = (long)i * G + c; mt = (int)(L / NT); pn = (int)(L % NT); }
        if (mt >= segt[16]) return false;
        int e = 0;
#pragma unroll
        for (int k = 1; k < 16; ++k) e += (segt[k] <= mt) ? 1 : 0;
        u.pm = mt; u.pn = pn; u.e = e; u.li = i; return true;
    }
};

__device__ __forceinline__ unsigned cvt_pk_bf16(float lo, float hi) { unsigned r; asm volatile("v_cvt_pk_bf16_f32 %0, %1, %2" : "=v"(r) : "v"(lo), "v"(hi)); return r; }

typedef int i32x8 __attribute__((ext_vector_type(8)));
typedef i32x8 __attribute__((aligned(16))) i32x8a;
template <class Epi, class Sched, bool GATHER, bool F8 = false>
__device__ __forceinline__ void gemm_phase(PG8_LAS unsigned char* lds, const Gemm g, const Sched& S, const Epi& E, const PG8_LAS int* rowcache, int tid_in) {
    int tid_ = tid_in; asm volatile("" : "+v"(tid_));
    const int tid = tid_, wid = __builtin_amdgcn_readfirstlane(tid >> 6), lane = tid & 63, wr = wid >> 2, wc = wid & 3, fr = lane & 15, fq = lane >> 4;
    const int K = F8 ? g.K / 2 : g.K, nt = K / BK;
    unsigned voffB[2], vA[2][2], nvA[2][2]; int sR[2], sC[2];
    const size_t kstep = (size_t)(BK * 2);
    const size_t hstep = (size_t)HALF * K * 2;
    const size_t tstep = 2 * hstep;
    const size_t hstepB = Epi::WIDE ? (size_t)32 * K * 2 : hstep;
#pragma unroll
    for (int i = 0; i < 2; ++i) { int R, C; stage_rc(tid * 16 + i * 8192, R, C); const int R31 = Epi::PERM ? perm32(R & 31) : (R & 31);
        const int Rb = Epi::WIDE ? ((R >> 5) * 64 + R31) : ((R & ~31) + R31); sR[i] = R; sC[i] = C;
        voffB[i] = (unsigned)(Rb * K + C) * 2u;
        vA[0][i] = (unsigned)(R * K + C) * 2u; vA[1][i] = vA[0][i] + (unsigned)hstep; }
    const unsigned ldsw = (unsigned)wid * 1024u;
    const int aoff = lds_byte(wr * 64 + fr, fq * 8), boff = lds_byte(wc * 32 + fr, fq * 8);
    const int aoff8 = lds_byte(wr * 64 + fr, (fq >> 1) * 32 + (fq & 1) * 16), boff8 = lds_byte(wc * 32 + fr, (fq >> 1) * 32 + (fq & 1) * 16);
#define PG8_SA(b, h) (((b) * 2 + (h)) * HTB)
#define PG8_SB(b, h) ((4 + (b) * 2 + (h)) * HTB)
#define PG8_STAGE(bufoff, gbase, voff) do { _Pragma("unroll") for (int _i = 0; _i < 2; ++_i) \
        __builtin_amdgcn_global_load_lds((const unsigned*)((const char*)(gbase) + (voff)[_i]), (PG8_LAS unsigned*)(lds + (bufoff) + ldsw + _i * 8192), 16, 0, 0); } while (0)
#define PG8_LDA(dst, b, h) do { _Pragma("unroll") for (int m = 0; m < 4; ++m) _Pragma("unroll") for (int k = 0; k < 2; ++k) dst[m][k] = *(const PG8_LAS bf16x8*)(lds + PG8_SA(b, h) + aoff + m * 2048 + k * 1024); } while (0)
#define PG8_LDB(dst, b, h) do { _Pragma("unroll") for (int n = 0; n < 2; ++n) _Pragma("unroll") for (int k = 0; k < 2; ++k) dst[n][k] = *(const PG8_LAS bf16x8*)(lds + PG8_SB(b, h) + boff + n * 2048 + k * 1024); } while (0)
#define PG8_MMA(ai, bj, At, Bt) do { __builtin_amdgcn_s_setprio(1); _Pragma("unroll") for (int m = 0; m < 4; ++m) _Pragma("unroll") for (int n = 0; n < 2; ++n) _Pragma("unroll") for (int k = 0; k < 2; ++k) \
        acc[ai][bj][m][n] = __builtin_amdgcn_mfma_f32_16x16x32_bf16(Bt[n][k], At[m][k], acc[ai][bj][m][n], 0, 0, 0); __builtin_amdgcn_s_setprio(0); } while (0)
#define PG8_LDA8(dst, b, h) do { _Pragma("unroll") for (int m = 0; m < 4; ++m) dst[m] = *(const PG8_LAS i32x8a*)(lds + PG8_SA(b, h) + aoff8 + m * 2048); } while (0)
#define PG8_LDB8(dst, b, h) do { _Pragma("unroll") for (int n = 0; n < 2; ++n) dst[n] = *(const PG8_LAS i32x8a*)(lds + PG8_SB(b, h) + boff8 + n * 2048); } while (0)
#define PG8_MMA8(ai, bj, At, Bt) do { __builtin_amdgcn_s_setprio(1); _Pragma("unroll") for (int m = 0; m < 4; ++m) _Pragma("unroll") for (int n = 0; n < 2; ++n) \
        acc[ai][bj][m][n] = __builtin_amdgcn_mfma_scale_f32_16x16x128_f8f6f4(Bt[n], At[m], acc[ai][bj][m][n], 0, 0, 0, g.sb, 0, g.sa); \
        _Pragma("unroll") for (int m = 0; m < 4; ++m) asm volatile("" : "+v"(acc[ai][bj][m][0]), "+v"(acc[ai][bj][m][1])); __builtin_amdgcn_s_setprio(0); } while (0)
#define PG8_WAIT_V(n) asm volatile("s_waitcnt vmcnt(" #n ")" ::: "memory")
#define PG8_WAIT_L(n) asm volatile("s_waitcnt lgkmcnt(" #n ")" ::: "memory")
#define PG8_BAR __builtin_amdgcn_s_barrier()
#define PG8_SCHED __builtin_amdgcn_sched_barrier(0)
#define PG8_GATHER(dst, u) do { _Pragma("unroll") for (int _h = 0; _h < 2; ++_h) _Pragma("unroll") for (int _i = 0; _i < 2; ++_i) \
        dst[_h][_i] = (unsigned)(rowcache[(u).li * 256 + _h * 128 + sR[_i]] * K + sC[_i]) * 2u; } while (0)
    Unit cur, nxt; int ui = 0;
    if (!S.next(0, cur)) return;
    if constexpr (GATHER) { PG8_GATHER(vA, cur); }
#pragma unroll
    for (int h = 0; h < 2; ++h)
#pragma unroll
        for (int i = 0; i < 2; ++i) nvA[h][i] = vA[h][i];
    f32x4 acc[2][2][4][2];
#pragma unroll
    for (int a = 0; a < 2; ++a)
#pragma unroll
        for (int b = 0; b < 2; ++b)
#pragma unroll
            for (int m = 0; m < 4; ++m)
#pragma unroll
                for (int n = 0; n < 2; ++n) acc[a][b][m][n] = (f32x4){0.f, 0.f, 0.f, 0.f};
    bf16x8 At[4][2], B0[2][2], B1[2][2]; i32x8 At8[4], B08[2], B18[2];
    const char* cA = (const char*)g.A + (GATHER ? (size_t)0 : (size_t)cur.pm * tstep);
    const char* cB = (const char*)g.Bt + ((size_t)cur.e * g.N + (size_t)cur.pn * BM) * K * 2;
    PG8_STAGE(PG8_SB(0, 0), cB, voffB); PG8_STAGE(PG8_SB(0, 1), cB + hstepB, voffB); PG8_STAGE(PG8_SA(0, 0), cA, vA[0]); PG8_STAGE(PG8_SA(0, 1), cA, vA[1]);
    PG8_STAGE(PG8_SB(1, 0), cB + kstep, voffB); PG8_STAGE(PG8_SA(1, 0), cA + kstep, vA[0]); PG8_STAGE(PG8_SB(1, 1), cB + hstepB + kstep, voffB);
    PG8_WAIT_V(6); PG8_BAR;
    if (wr == 1) PG8_BAR;
    for (;;) {
        const bool has_next = S.next(ui + 1, nxt);
        const char* nA = has_next ? (const char*)g.A + (GATHER ? (size_t)0 : (size_t)nxt.pm * tstep) : cA;
        const char* nB = has_next ? (const char*)g.Bt + ((size_t)nxt.e * g.N + (size_t)nxt.pn * BM) * K * 2 : cB;
#pragma unroll 1
        for (int t = 0; t < nt; t += 2) {
            const bool last = (t == nt - 2);
            const char* a1 = cA + (size_t)(t + 1) * kstep;
            const char* a2 = last ? nA : cA + (size_t)(t + 2) * kstep; const char* b2 = last ? nB : cB + (size_t)(t + 2) * kstep;
            const char* a3 = a2 + kstep; const char* b3 = b2 + kstep;
            if constexpr (GATHER) { if (last && has_next) { PG8_GATHER(nvA, nxt); } }
            unsigned sA[2][2];
#pragma unroll
            for (int h = 0; h < 2; ++h)
#pragma unroll
                for (int i = 0; i < 2; ++i) sA[h][i] = (GATHER && last) ? nvA[h][i] : vA[h][i];
            if constexpr (!F8) {
            PG8_LDB(B0, 0, 0); PG8_LDB(B1, 0, 1); PG8_SCHED; PG8_LDA(At, 0, 0); PG8_STAGE(PG8_SA(1, 1), a1, vA[1]);
            PG8_WAIT_V(8); PG8_WAIT_L(0); PG8_BAR; PG8_MMA(0, 0, At, B0); PG8_MMA(0, 1, At, B1); PG8_BAR; PG8_SCHED;
            PG8_LDA(At, 0, 1); PG8_STAGE(PG8_SB(0, 0), b2, voffB); PG8_STAGE(PG8_SB(0, 1), b2 + hstepB, voffB); PG8_STAGE(PG8_SA(0, 0), a2, sA[0]);
            PG8_WAIT_V(8); PG8_WAIT_L(0); PG8_BAR; PG8_MMA(1, 0, At, B0); PG8_MMA(1, 1, At, B1); PG8_BAR; PG8_SCHED;
            PG8_LDB(B0, 1, 0); PG8_LDB(B1, 1, 1); PG8_SCHED; PG8_LDA(At, 1, 0); PG8_STAGE(PG8_SA(0, 1), a2, sA[1]);
            PG8_WAIT_V(8); PG8_WAIT_L(0); PG8_BAR; PG8_MMA(0, 0, At, B0); PG8_MMA(0, 1, At, B1); PG8_BAR; PG8_SCHED;
            PG8_LDA(At, 1, 1); PG8_STAGE(PG8_SB(1, 0), b3, voffB); PG8_STAGE(PG8_SB(1, 1), b3 + hstepB, voffB); PG8_STAGE(PG8_SA(1, 0), a3, sA[0]);
            PG8_WAIT_V(8); PG8_WAIT_L(0); PG8_BAR; PG8_MMA(1, 0, At, B0); PG8_MMA(1, 1, At, B1); PG8_BAR; PG8_SCHED;
            } else {
            PG8_LDB8(B08, 0, 0); PG8_LDB8(B18, 0, 1); PG8_SCHED; PG8_LDA8(At8, 0, 0); PG8_STAGE(PG8_SA(1, 1), a1, vA[1]);
            PG8_WAIT_V(8); PG8_WAIT_L(0); PG8_BAR; PG8_MMA8(0, 0, At8, B08); PG8_MMA8(0, 1, At8, B18); PG8_BAR; PG8_SCHED;
            PG8_LDA8(At8, 0, 1); PG8_STAGE(PG8_SB(0, 0), b2, voffB); PG8_STAGE(PG8_SB(0, 1), b2 + hstepB, voffB); PG8_STAGE(PG8_SA(0, 0), a2, sA[0]);
            PG8_WAIT_V(8); PG8_WAIT_L(0); PG8_BAR; PG8_MMA8(1, 0, At8, B08); PG8_MMA8(1, 1, At8, B18); PG8_BAR; PG8_SCHED;
            PG8_LDB8(B08, 1, 0); PG8_LDB8(B18, 1, 1); PG8_SCHED; PG8_LDA8(At8, 1, 0); PG8_STAGE(PG8_SA(0, 1), a2, sA[1]);
            PG8_WAIT_V(8); PG8_WAIT_L(0); PG8_BAR; PG8_MMA8(0, 0, At8, B08); PG8_MMA8(0, 1, At8, B18); PG8_BAR; PG8_SCHED;
            PG8_LDA8(At8, 1, 1); PG8_STAGE(PG8_SB(1, 0), b3, voffB); PG8_STAGE(PG8_SB(1, 1), b3 + hstepB, voffB); PG8_STAGE(PG8_SA(1, 0), a3, sA[0]);
            PG8_WAIT_V(8); PG8_WAIT_L(0); PG8_BAR; PG8_MMA8(1, 0, At8, B08); PG8_MMA8(1, 1, At8, B18); PG8_BAR; PG8_SCHED;
            }
        }
        if constexpr (F8) {
#pragma unroll
            for (int a = 0; a < 2; ++a)
#pragma unroll
                for (int b = 0; b < 2; ++b)
#pragma unroll
                    for (int m = 0; m < 4; ++m) asm volatile("" : "+v"(acc[a][b][m][0]), "+v"(acc[a][b][m][1])); }
        if (wr == 0) PG8_BAR;
        E(acc, cur, wr, wc, fr, fq);
        if (!has_next) break;
#pragma unroll
        for (int a = 0; a < 2; ++a)
#pragma unroll
            for (int b = 0; b < 2; ++b)
#pragma unroll
                for (int m = 0; m < 4; ++m)
#pragma unroll
                    for (int n = 0; n < 2; ++n) acc[a][b][m][n] = (f32x4){0.f, 0.f, 0.f, 0.f};
        cur = nxt; cA = nA; cB = nB; ++ui;
#pragma unroll
        for (int h = 0; h < 2; ++h)
#pragma unroll
            for (int i = 0; i < 2; ++i) vA[h][i] = nvA[h][i];
        if (wr == 1) PG8_BAR;
    }
    PG8_WAIT_V(0);
    PG8_BAR;
#undef PG8_SA
#undef PG8_SB
#undef PG8_STAGE
#undef PG8_LDA
#undef PG8_LDB
#undef PG8_MMA
#undef PG8_LDA8
#undef PG8_LDB8
#undef PG8_MMA8
#undef PG8_WAIT_V
#undef PG8_WAIT_L
#undef PG8_BAR
#undef PG8_SCHED
#undef PG8_GATHER
}
}

#define XB_TMO      128
#define XB_XCNT(j)  (256  + 64 * (j))
#define XB_XSUB(j)  (1280 + 64 * (j))
#define XB_XGEN(j)  (2304 + 64 * (j))
#define XB_TOP      3328
#define XB_TOPGEN   3392
#define XCD_BAR_WORDS 3456
#define XB_SPIN_CAP (1u << 18)
__device__ __forceinline__ unsigned xb_ld(unsigned* p)              { return __hip_atomic_load(p, __ATOMIC_RELAXED, __HIP_MEMORY_SCOPE_AGENT); }
__device__ __forceinline__ unsigned xb_add(unsigned* p, unsigned v) { return __hip_atomic_fetch_add(p, v, __ATOMIC_RELAXED, __HIP_MEMORY_SCOPE_AGENT); }
__device__ __forceinline__ unsigned xb_xcc_id() { return (unsigned)__builtin_amdgcn_s_getreg((3 << 11) | 20) & 0xFu; }
#define XB_SPIN(cond, bar) do { unsigned _sp = 0; while (cond) { __builtin_amdgcn_s_sleep(1); \
    if ((++_sp & 255u) == 0u) { if (xb_ld(&(bar)[XB_TMO])) break; if (_sp > XB_SPIN_CAP) { atomicAdd(&(bar)[XB_TMO], 1u); break; } } } } while (0)
struct XcdBarrier { unsigned* bar; unsigned x; volatile LAS unsigned* st; };
__device__ __forceinline__ XcdBarrier xcd_barrier_post(unsigned* bar, volatile LAS unsigned* st) {
    XcdBarrier b; b.bar = bar; b.x = xb_xcc_id(); b.st = st;
    if (threadIdx.x == 0) (void)xb_add(&bar[XB_XCNT(b.x)], 1u);
    return b;
}
__device__ __forceinline__ void xcd_barrier_complete(unsigned* bar, unsigned x, unsigned& nloc, unsigned& nx) {
    const unsigned G = gridDim.x * gridDim.y * gridDim.z;
    unsigned sum, cnt, mine, sp = 0u;
    for (;;) {
        sum = 0u; cnt = 0u; mine = 0u;
#pragma unroll
        for (unsigned j = 0; j < 16; ++j) { const unsigned c = xb_ld(&bar[XB_XCNT(j)]); sum += c; cnt += (c > 0u) ? 1u : 0u; mine = (j == x) ? c : mine; }
        if (sum == G) break;
        __builtin_amdgcn_s_sleep(1);
        if ((++sp & 255u) == 0u) { if (xb_ld(&bar[XB_TMO])) break; if (sp > XB_SPIN_CAP) { atomicAdd(&bar[XB_TMO], 1u); break; } }
    }
    nloc = mine > 0u ? mine : 1u; nx = cnt > 0u ? cnt : 1u;
}
__device__ __forceinline__ void xcd_barrier(const XcdBarrier& b, int tid) {
    asm volatile("s_waitcnt vmcnt(0)" ::: "memory");
    __syncthreads();
    if (tid == 0) {
        unsigned* bar = b.bar;
        __builtin_amdgcn_s_waitcnt(0);
        unsigned nloc = b.st[0], nx = b.st[1];
        if (nloc == 0u) { xcd_barrier_complete(bar, b.x, nloc, nx); b.st[0] = nloc; b.st[1] = nx; }
        const unsigned old = xb_add(&bar[XB_XSUB(b.x)], 1u);
        const unsigned gen = old / nloc;
        if (old + 1u == (gen + 1u) * nloc) {
            __builtin_amdgcn_fence(__ATOMIC_RELEASE, "agent");
            asm volatile("s_waitcnt vmcnt(0)" ::: "memory");
            const unsigned og = xb_add(&bar[XB_TOP], 1u);
            const unsigned tg = og / nx;
            if (og + 1u == (tg + 1u) * nx) xb_add(&bar[XB_TOPGEN], 1u);
            else XB_SPIN(xb_ld(&bar[XB_TOPGEN]) == tg, bar);
            __builtin_amdgcn_fence(__ATOMIC_ACQUIRE, "agent");
            xb_add(&bar[XB_XGEN(b.x)], 1u);
            asm volatile("s_waitcnt vmcnt(0)" ::: "memory");
        } else {
            XB_SPIN(xb_ld(&bar[XB_XGEN(b.x)]) == gen, bar);
            __builtin_amdgcn_fence(__ATOMIC_ACQUIRE, "agent");
            asm volatile("s_waitcnt vmcnt(0)" ::: "memory");
        }
    }
    __syncthreads();
}

struct Args { const GAS float* in[28]; GAS float* out; GAS unsigned char* ws; };
enum { I_X = 0, I_C, I_CTX, I_CCTX, I_ADAW, I_ADAB, I_N1G, I_N2G, I_FING, I_WIN, I_LRE, I_LIM, I_LDT, I_BRE, I_BIM, I_CRE, I_CIM, I_SD, I_WGLU, I_ALAM, I_SUBG, I_WAO, I_WO, I_RW, I_RB, I_W1, I_W3, I_W2 };

#define GIN(F_, i_) ((const float*)((F_).in[(i_)]))
struct Frame {
    LAS unsigned char* lds; volatile LAS unsigned* MISC;
    int tid, lane, wave, vcu, G;
    const GAS float* const* in; GAS float* out; GAS unsigned char* ws;
};

__device__ __forceinline__ void transpose_item(const float* W, int K, int N, bf16* WT, int k0, int n0, int drow0, LAS float* scr, int lane, const float* rs = nullptr) {
    float v[32];
    const float* wp = W + (size_t)(k0 + (lane >> 5)) * N + n0 + (lane & 31);
#pragma unroll
    for (int i = 0; i < 32; ++i) v[i] = wp[(size_t)(2 * i) * N];
    if (rs) {
#pragma unroll
        for (int i = 0; i < 32; ++i) v[i] *= rs[(k0 + (lane >> 5) + 2 * i) & 127]; }
#pragma unroll
    for (int i = 0; i < 32; ++i) scr[(2 * i + (lane >> 5)) * 33 + (lane & 31)] = v[i];
    LDS_WAIT(); asm volatile("" ::: "memory");
    const int c = lane & 7;
#pragma unroll
    for (int j = 0; j < 4; ++j) { const int n = (lane >> 3) + 8 * j; const LAS float* s = scr + (8 * c) * 33 + n;
        u32x4 o; o.x = pk2(s[0 * 33], s[1 * 33]); o.y = pk2(s[2 * 33], s[3 * 33]); o.z = pk2(s[4 * 33], s[5 * 33]); o.w = pk2(s[6 * 33], s[7 * 33]);
        *(u32x4*)(WT + (size_t)(drow0 + n) * K + k0 + 8 * c) = o; }
    LDS_WAIT(); asm volatile("" ::: "memory");
}
__device__ __forceinline__ void transpose_item_f8(const float* W, int K, int N, unsigned char* WT, int k0, int n0, int drow0, LAS float* scr, int lane) {
    float v[32];
    const float* wp = W + (size_t)(k0 + (lane >> 5)) * N + n0 + (lane & 31);
#pragma unroll
    for (int i = 0; i < 32; ++i) v[i] = wp[(size_t)(2 * i) * N];
#pragma unroll
    for (int i = 0; i < 32; ++i) scr[(2 * i + (lane >> 5)) * 33 + (lane & 31)] = v[i] * F8_SW;
    LDS_WAIT(); asm volatile("" ::: "memory");
    const int c = lane & 7;
#pragma unroll
    for (int j = 0; j < 4; ++j) { const int n = (lane >> 3) + 8 * j; const LAS float* s = scr + (8 * c) * 33 + n;
        u32x2 o; o.x = pk4_fp8(s[0 * 33], s[1 * 33], s[2 * 33], s[3 * 33]); o.y = pk4_fp8(s[4 * 33], s[5 * 33], s[6 * 33], s[7 * 33]);
        *(u32x2*)(WT + (size_t)(drow0 + n) * K + k0 + 8 * c) = o; }
    LDS_WAIT(); asm volatile("" ::: "memory");
}
__device__ __forceinline__ int ileave128(int n0, int second) { return (n0 >> 7) * 256 + second * 128 + (n0 & 127); }
struct CvtItem { const GAS float* W; GAS unsigned char* WT; int K, N, k0, n0, drow0, kind; };
__device__ __forceinline__ CvtItem cvt_decode(Frame& F, int l, int it, GAS unsigned char* wsw) {
    constexpr int I_IN = 16 * 128, I_GLU = 8 * 64, I_AO = 8 * 32, I_O = 16 * 32, I_EX = 16 * 32;
    CvtItem c; int r = it;
    if (r < I_IN) { const int kb = r / 128, nb = r % 128; c.W = F.in[I_WIN] + (size_t)l * D * NCOL; c.WT = wsw + WS_WIN; c.K = D; c.N = NCOL; c.k0 = 64 * kb; c.n0 = 32 * nb; c.drow0 = 32 * nb; c.kind = 1; return c; } r -= I_IN;
    if (r < I_GLU) { const int kb = r / 64, nb = r % 64, n0 = 32 * nb; c.W = F.in[I_WGLU] + (size_t)l * 512 * 2048; c.WT = wsw + WS_WGLU; c.K = 512; c.N = 2048; c.k0 = 64 * kb; c.n0 = n0;
        c.drow0 = n0 < 1024 ? ileave128(n0, 0) : ileave128(n0 - 1024, 1); c.kind = 1; return c; } r -= I_GLU;
    if (r < I_AO) { const int kb = r / 32, nb = r % 32; c.W = F.in[I_WAO] + (size_t)l * 512 * 1024; c.WT = wsw + WS_WAO; c.K = 512; c.N = 1024; c.k0 = 64 * kb; c.n0 = 32 * nb; c.drow0 = 32 * nb; c.kind = 1; return c; } r -= I_AO;
    if (r < I_O) { const int kb = r / 32, nb = r % 32; c.W = F.in[I_WO] + (size_t)l * D * D; c.WT = wsw + WS_WO; c.K = D; c.N = D; c.k0 = 64 * kb; c.n0 = 32 * nb; c.drow0 = 32 * nb; c.kind = 1; return c; } r -= I_O;
    { const int e = r / (3 * I_EX), q = r % (3 * I_EX), which = q / I_EX, ii = q % I_EX, kb = ii / 32, nb = ii % 32, n0 = 32 * nb;
      const size_t woff = ((size_t)l * NE + e) * D * D;
      c.W = (which == 0 ? F.in[I_W1] : which == 1 ? F.in[I_W3] : F.in[I_W2]) + woff;
      c.WT = which == 2 ? wsw + WS_W2 + (size_t)e * D * D : wsw + WS_W13 + (size_t)e * 2048 * D;
      c.K = D; c.N = D; c.k0 = 64 * kb; c.n0 = n0; c.drow0 = which == 2 ? n0 : ileave128(n0, which); c.kind = 1; }
    return c;
}
__device__ __forceinline__ void cvt_load(const CvtItem& c, float (&v)[32], int lane) {
    const GAS float* wp = c.W + (size_t)(c.k0 + (lane >> 5)) * c.N + c.n0 + (lane & 31);
#pragma unroll
    for (int i = 0; i < 32; ++i) v[i] = wp[(size_t)(2 * i) * c.N];
}
__device__ __forceinline__ void cvt_store(const CvtItem& c, const float (&v)[32], LAS float* scr, int lane) {
    const float sc = c.kind ? F8_SW : 1.0f;
#pragma unroll
    for (int i = 0; i < 32; ++i) scr[(2 * i + (lane >> 5)) * 33 + (lane & 31)] = v[i] * sc;
    LDS_WAIT(); asm volatile("" ::: "memory");
    const int cc = lane & 7;
    if (c.kind) {
#pragma unroll
        for (int j = 0; j < 4; ++j) { const int n = (lane >> 3) + 8 * j; const LAS float* s = scr + (8 * cc) * 33 + n;
            u32x2 o; o.x = pk4_fp8(s[0 * 33], s[1 * 33], s[2 * 33], s[3 * 33]); o.y = pk4_fp8(s[4 * 33], s[5 * 33], s[6 * 33], s[7 * 33]);
            *(GAS u32x2*)(c.WT + (size_t)(c.drow0 + n) * c.K + c.k0 + 8 * cc) = o; }
    } else {
#pragma unroll
        for (int j = 0; j < 4; ++j) { const int n = (lane >> 3) + 8 * j; const LAS float* s = scr + (8 * cc) * 33 + n;
            u32x4 o; o.x = pk2(s[0 * 33], s[1 * 33]); o.y = pk2(s[2 * 33], s[3 * 33]); o.z = pk2(s[4 * 33], s[5 * 33]); o.w = pk2(s[6 * 33], s[7 * 33]);
            *(GAS u32x4*)(c.WT + ((size_t)(c.drow0 + n) * c.K + c.k0 + 8 * cc) * 2) = o; }
    }
    LDS_WAIT(); asm volatile("" ::: "memory");
}
__device__ __forceinline__ void convert_weights(Frame& F, int l, int widx, int nw, LAS float* scr) {
    const int gw = F.vcu * nw + widx, NGW = F.G * nw;
    GAS unsigned char* const wsw = F.ws + ((l & 1) ? WS_WALT : 0);
    constexpr int NITEMS = 16 * 128 + 8 * 64 + 8 * 32 + 16 * 32 + NE * 3 * 16 * 32;
#pragma unroll 1
    for (int it = gw; it < NITEMS; it += 2 * NGW) {
        const bool two = it + NGW < NITEMS;
        const CvtItem a = cvt_decode(F, l, it, wsw), b = cvt_decode(F, l, two ? it + NGW : it, wsw);
        float va[32], vb[32];
        cvt_load(a, va, F.lane); cvt_load(b, vb, F.lane);
        cvt_store(a, va, scr, F.lane);
        if (two) cvt_store(b, vb, scr, F.lane);
    }
}

__device__ __forceinline__ void p0_mods(Frame& F) {
    LAS float* sc = (LAS float*)F.lds;
    LAS float* red = (LAS float*)(F.lds + 17 * 1024 * 4);
    const float* c = GIN(F, I_C); const float* cc = GIN(F, I_CCTX);
    for (int i = F.tid; i < 17 * 1024; i += NTHREADS) { const float v = i < 16 * 1024 ? c[i] : cc[i - 16 * 1024]; sc[i] = v / (1.0f + __expf(-v)); }
    __syncthreads();
    float* mods = (float*)(F.ws + WS_MODS);
    for (int item = blockIdx.x; item < DEPTH * 96; item += F.G) {
        const int l = item / 96, jc = item % 96;
        const float* W = GIN(F, I_ADAW) + (size_t)l * D * 6144 + jc * 64 + F.lane;
        float acc[17];
#pragma unroll
        for (int r = 0; r < 17; ++r) acc[r] = 0.f;
        const int kb = F.wave * 128;
#pragma unroll 4
        for (int k = 0; k < 128; ++k) { const float w = W[(size_t)(kb + k) * 6144];
#pragma unroll
            for (int r = 0; r < 17; ++r) acc[r] += sc[r * 1024 + kb + k] * w; }
#pragma unroll
        for (int r = 0; r < 17; ++r) red[(F.wave * 17 + r) * 64 + F.lane] = acc[r];
        __syncthreads();
        for (int o = F.tid; o < 17 * 64; o += NTHREADS) { const int r = o / 64, j = o % 64; float s = 0.f;
#pragma unroll
            for (int w = 0; w < 8; ++w) s += red[(w * 17 + r) * 64 + j];
            mods[((size_t)l * 17 + r) * 6144 + jc * 64 + j] = s + GIN(F, I_ADAB)[l * 6144 + jc * 64 + j]; }
        __syncthreads();
    }
    if (blockIdx.x == 0) { f32x2* rope = (f32x2*)(F.ws + WS_ROPE);
        for (int i = F.tid; i < 64 * 16; i += NTHREADS) { const int pos = i / 16, f = i % 16; const float inv = powf(10000.0f, -(float)f / 16.0f); const float ang = (float)pos * inv;
            rope[i] = (f32x2){cosf(ang), sinf(ang)}; } }
}

__device__ __forceinline__ void load_segt(Frame& F, int lc) {
    const unsigned* cnt = (const unsigned*)(F.ws + WS_CTL) + CW_CNT + lc * 64;
    if (F.tid < 16) F.MISC[96 + F.tid] = __hip_atomic_load(cnt + F.tid, __ATOMIC_RELAXED, __HIP_MEMORY_SCOPE_AGENT);
    __syncthreads();
    if (F.tid < 17) { int s = 0;
#pragma unroll
        for (int e = 0; e < 16; ++e) { const int t = ((int)F.MISC[96 + e] + 255) >> 8; s += e < F.tid ? t : 0; }
        F.MISC[32 + F.tid] = (unsigned)s; }
    __syncthreads();
}

struct Row { f32x4 v[4]; };
__device__ __forceinline__ void row_load(Row& r, const float* p, int lane) { const f32x4* q = (const f32x4*)p + lane;
#pragma unroll
    for (int j = 0; j < 4; ++j) r.v[j] = q[64 * j]; }
__device__ __forceinline__ void row_load_bf16(Row& r, const bf16* p, int lane) { const u32x2* q = (const u32x2*)p + lane;
#pragma unroll
    for (int j = 0; j < 4; ++j) { const u32x2 w = q[64 * j]; r.v[j] = (f32x4){bflo(w.x), bfhi(w.x), bflo(w.y), bfhi(w.y)}; } }
__device__ __forceinline__ void row_store(const Row& r, float* p, int lane) { f32x4* q = (f32x4*)p + lane;
#pragma unroll
    for (int j = 0; j < 4; ++j) q[64 * j] = r.v[j]; }
__device__ __forceinline__ float row_rms_scale(const Row& r, float eps) { float s = 0.f;
#pragma unroll
    for (int j = 0; j < 4; ++j) s += (r.v[j].x * r.v[j].x + r.v[j].y * r.v[j].y) + (r.v[j].z * r.v[j].z + r.v[j].w * r.v[j].w);
    return rsqrtf(wave_sum(s) * (1.0f / D) + eps); }
__device__ __forceinline__ void row_add_moe(Frame& F, Row& r, int row, const f32x4 (&g2c)[4], int lane) {
    const unsigned* ti = (const unsigned*)(F.ws + WS_TOKINFO) + 2 * row; const float* tw = (const float*)(F.ws + WS_TOKW) + 2 * row;
    const unsigned i0 = ti[0], i1 = ti[1]; const float w0 = tw[0], w1 = tw[1];
    const size_t s0 = (size_t)F.MISC[32 + (i0 >> 24)] * 256 + (i0 & 0xffffffu), s1 = (size_t)F.MISC[32 + (i1 >> 24)] * 256 + (i1 & 0xffffffu);
    const unsigned* y0 = (const unsigned*)((const unsigned char*)(F.ws + WS_YS) + s0 * D) + lane; const unsigned* y1 = (const unsigned*)((const unsigned char*)(F.ws + WS_YS) + s1 * D) + lane;
    const float v0 = w0 * (1.0f / F8_SY), v1 = w1 * (1.0f / F8_SY);
#pragma unroll
    for (int j = 0; j < 4; ++j) { const unsigned a = y0[64 * j], b = y1[64 * j]; const f32x4 g = g2c[j];
        const f32x2 a01 = __builtin_amdgcn_cvt_pk_f32_fp8((int)a, false), a23 = __builtin_amdgcn_cvt_pk_f32_fp8((int)a, true);
        const f32x2 b01 = __builtin_amdgcn_cvt_pk_f32_fp8((int)b, false), b23 = __builtin_amdgcn_cvt_pk_f32_fp8((int)b, true);
        r.v[j].x += g.x * (v0 * a01.x + v1 * b01.x); r.v[j].y += g.y * (v0 * a01.y + v1 * b01.y);
        r.v[j].z += g.z * (v0 * a23.x + v1 * b23.x); r.v[j].w += g.w * (v0 * a23.y + v1 * b23.y); }
}
__device__ __forceinline__ void row_add_moe2(Frame& F, Row& ra, Row& rb, int rowa, int rowb, const f32x4 (&g2c)[4], int lane) {
    const unsigned* tia = (const unsigned*)(F.ws + WS_TOKINFO) + 2 * rowa; const float* twa = (const float*)(F.ws + WS_TOKW) + 2 * rowa;
    const unsigned* tib = (const unsigned*)(F.ws + WS_TOKINFO) + 2 * rowb; const float* twb = (const float*)(F.ws + WS_TOKW) + 2 * rowb;
    const unsigned a0i = tia[0], a1i = tia[1], b0i = tib[0], b1i = tib[1]; const float wa0 = twa[0], wa1 = twa[1], wb0 = twb[0], wb1 = twb[1];
    const size_t sa0 = (size_t)F.MISC[32 + (a0i >> 24)] * 256 + (a0i & 0xffffffu), sa1 = (size_t)F.MISC[32 + (a1i >> 24)] * 256 + (a1i & 0xffffffu);
    const size_t sb0 = (size_t)F.MISC[32 + (b0i >> 24)] * 256 + (b0i & 0xffffffu), sb1 = (size_t)F.MISC[32 + (b1i >> 24)] * 256 + (b1i & 0xffffffu);
    const unsigned char* ys = (const unsigned char*)(F.ws + WS_YS);
    const unsigned* ya0 = (const unsigned*)(ys + sa0 * D) + lane; const unsigned* ya1 = (const unsigned*)(ys + sa1 * D) + lane;
    const unsigned* yb0 = (const unsigned*)(ys + sb0 * D) + lane; const unsigned* yb1 = (const unsigned*)(ys + sb1 * D) + lane;
    unsigned qa0[4], qa1[4], qb0[4], qb1[4];
#pragma unroll
    for (int j = 0; j < 4; ++j) { qa0[j] = ya0[64 * j]; qa1[j] = ya1[64 * j]; qb0[j] = yb0[64 * j]; qb1[j] = yb1[64 * j]; }
    const float va0 = wa0 * (1.0f / F8_SY), va1 = wa1 * (1.0f / F8_SY), vb0 = wb0 * (1.0f / F8_SY), vb1 = wb1 * (1.0f / F8_SY);
#pragma unroll
    for (int j = 0; j < 4; ++j) { const f32x4 g = g2c[j];
        { const unsigned a = qa0[j], b = qa1[j];
          const f32x2 a01 = __builtin_amdgcn_cvt_pk_f32_fp8((int)a, false), a23 = __builtin_amdgcn_cvt_pk_f32_fp8((int)a, true), b01 = __builtin_amdgcn_cvt_pk_f32_fp8((int)b, false), b23 = __builtin_amdgcn_cvt_pk_f32_fp8((int)b, true);
          ra.v[j].x += g.x * (va0 * a01.x + va1 * b01.x); ra.v[j].y += g.y * (va0 * a01.y + va1 * b01.y); ra.v[j].z += g.z * (va0 * a23.x + va1 * b23.x); ra.v[j].w += g.w * (va0 * a23.y + va1 * b23.y); }
        { const unsigned a = qb0[j], b = qb1[j];
          const f32x2 a01 = __builtin_amdgcn_cvt_pk_f32_fp8((int)a, false), a23 = __builtin_amdgcn_cvt_pk_f32_fp8((int)a, true), b01 = __builtin_amdgcn_cvt_pk_f32_fp8((int)b, false), b23 = __builtin_amdgcn_cvt_pk_f32_fp8((int)b, true);
          rb.v[j].x += g.x * (vb0 * a01.x + vb1 * b01.x); rb.v[j].y += g.y * (vb0 * a01.y + vb1 * b01.y); rb.v[j].z += g.z * (vb0 * a23.x + vb1 * b23.x); rb.v[j].w += g.w * (vb0 * a23.y + vb1 * b23.y); } }
}
__device__ __forceinline__ void row_modulate(Row& r, float rs, const float* gn, const float* sc, const float* sh, int lane) {
    const f32x4* a = (const f32x4*)gn + lane; const f32x4* b = (const f32x4*)sc + lane; const f32x4* c = (const f32x4*)sh + lane;
#pragma unroll
    for (int j = 0; j < 4; ++j) { const f32x4 g = a[64 * j], s = b[64 * j], h = c[64 * j]; r.v[j] = r.v[j] * rs * g * (1.0f + s) + h; }
}
struct ModTab { f32x4 gs[4], sh[4]; };
__device__ __forceinline__ void modtab_load(ModTab& t, const float* gn, const float* sc, const float* sh, int lane) {
    const f32x4* a = (const f32x4*)gn + lane; const f32x4* b = (const f32x4*)sc + lane; const f32x4* c = (const f32x4*)sh + lane;
#pragma unroll
    for (int j = 0; j < 4; ++j) { t.gs[j] = a[64 * j] * (1.0f + b[64 * j]); t.sh[j] = c[64 * j]; }
}
__device__ __forceinline__ void row_modulate_t(Row& r, float rs, const ModTab& t) {
#pragma unroll
    for (int j = 0; j < 4; ++j) r.v[j] = r.v[j] * rs * t.gs[j] + t.sh[j];
}
__device__ __forceinline__ void row_store_fp8(const Row& r, unsigned char* p, float s, int lane) { unsigned* q = (unsigned*)p + lane;
#pragma unroll
    for (int j = 0; j < 4; ++j) q[64 * j] = pk4_fp8(r.v[j].x * s, r.v[j].y * s, r.v[j].z * s, r.v[j].w * s); }
__device__ __forceinline__ void row_store_bf16(const Row& r, bf16* p, int lane) { u32x2* q = (u32x2*)p + lane;
#pragma unroll
    for (int j = 0; j < 4; ++j) q[64 * j] = (u32x2){pk2(r.v[j].x, r.v[j].y), pk2(r.v[j].z, r.v[j].w)}; }

__device__ __forceinline__ void phase_a(Frame& F, int l) {
    const int gw = F.vcu * NWAVES + F.wave, NGW = F.G * NWAVES;
    const float* mods = (const float*)(F.ws + WS_MODS);
    bf16* xres = (bf16*)(F.ws + WS_XRES); bf16* H = (bf16*)(F.ws + WS_H);
    const int per = (T + NGW - 1) / NGW, r0 = gw * per, r1 = r0 + per < T ? r0 + per : T;
    int mr_c = -1; ModTab mt; f32x4 g2c[4];
#pragma unroll
    for (int j = 0; j < 4; ++j) { float z_ = 0.f; asm volatile("" : "+v"(z_)); mt.gs[j] = (f32x4){z_, z_, z_, z_}; mt.sh[j] = mt.gs[j]; g2c[j] = mt.gs[j]; }
#pragma unroll 1
    for (int row = r0; row < r1; row += 2) {
        const int rowb = row + 1 < r1 ? row + 1 : row;
        const int mr = row < TL ? (row >> 11) : 16, mrb = rowb < TL ? (rowb >> 11) : 16; Row r, rb;
        if (mr != mr_c) { mr_c = mr; const float* m = mods + ((size_t)l * 17 + mr) * 6144; modtab_load(mt, GIN(F, I_N1G) + l * D, m + 1024, m, F.lane);
            if (l > 0) { const f32x4* gq = (const f32x4*)(mods + ((size_t)(l - 1) * 17 + mr) * 6144 + 5 * 1024) + F.lane;
#pragma unroll
                for (int j = 0; j < 4; ++j) g2c[j] = gq[64 * j]; } }
        if (mrb != mr) {
            if (l == 0) row_load(r, row < TL ? GIN(F, I_X) + (size_t)row * D : GIN(F, I_CTX) + (size_t)(row - TL) * D, F.lane);
            else { row_load_bf16(r, xres + (size_t)row * D, F.lane); row_add_moe(F, r, row, g2c, F.lane); }
            row_store_bf16(r, xres + (size_t)row * D, F.lane);
            { const float rs = row_rms_scale(r, NORM_EPS); row_modulate_t(r, rs, mt); }
            row_store_fp8(r, (unsigned char*)H + (size_t)row * D, F8_SX, F.lane);
            mr_c = mrb; { const float* m = mods + ((size_t)l * 17 + mrb) * 6144; modtab_load(mt, GIN(F, I_N1G) + l * D, m + 1024, m, F.lane);
              if (l > 0) { const f32x4* gq = (const f32x4*)(mods + ((size_t)(l - 1) * 17 + mrb) * 6144 + 5 * 1024) + F.lane;
#pragma unroll
                for (int j = 0; j < 4; ++j) g2c[j] = gq[64 * j]; } }
            if (l == 0) row_load(rb, rowb < TL ? GIN(F, I_X) + (size_t)rowb * D : GIN(F, I_CTX) + (size_t)(rowb - TL) * D, F.lane);
            else { row_load_bf16(rb, xres + (size_t)rowb * D, F.lane); row_add_moe(F, rb, rowb, g2c, F.lane); }
            row_store_bf16(rb, xres + (size_t)rowb * D, F.lane);
            { const float rs = row_rms_scale(rb, NORM_EPS); row_modulate_t(rb, rs, mt); }
            row_store_fp8(rb, (unsigned char*)H + (size_t)rowb * D, F8_SX, F.lane);
            continue; }
        if (l == 0) { row_load(r, row < TL ? GIN(F, I_X) + (size_t)row * D : GIN(F, I_CTX) + (size_t)(row - TL) * D, F.lane);
                      row_load(rb, rowb < TL ? GIN(F, I_X) + (size_t)rowb * D : GIN(F, I_CTX) + (size_t)(rowb - TL) * D, F.lane); }
        else { row_load_bf16(r, xres + (size_t)row * D, F.lane); row_load_bf16(rb, xres + (size_t)rowb * D, F.lane);
               row_add_moe2(F, r, rb, row, rowb, g2c, F.lane); }
        row_store_bf16(r, xres + (size_t)row * D, F.lane); row_store_bf16(rb, xres + (size_t)rowb * D, F.lane);
        { const float rs = row_rms_scale(r, NORM_EPS); row_modulate_t(r, rs, mt); }
        { const float rs = row_rms_scale(rb, NORM_EPS); row_modulate_t(rb, rs, mt); }
        row_store_fp8(r, (unsigned char*)H + (size_t)row * D, F8_SX, F.lane); row_store_fp8(rb, (unsigned char*)H + (size_t)rowb * D, F8_SX, F.lane);
    }
}
__device__ __forceinline__ void phase_final(Frame& F) {
    const int gw = F.vcu * NWAVES + F.wave, NGW = F.G * NWAVES;
    const float* mods = (const float*)(F.ws + WS_MODS); const bf16* xres = (const bf16*)(F.ws + WS_XRES);
    const int per = (TL + NGW - 1) / NGW, r0 = gw * per, r1 = r0 + per < TL ? r0 + per : TL;
    f32x4 fg[4], g2c[4]; int mr_c = -1;
#pragma unroll
    for (int j = 0; j < 4; ++j) { float z_ = 0.f; asm volatile("" : "+v"(z_)); fg[j] = ((const f32x4*)GIN(F, I_FING) + F.lane)[64 * j]; g2c[j] = (f32x4){z_, z_, z_, z_}; }
#pragma unroll 1
    for (int row = r0; row < r1; ++row) {
        const int mr = row >> 11;
        if (mr != mr_c) { mr_c = mr; const f32x4* gq = (const f32x4*)(mods + ((size_t)(DEPTH - 1) * 17 + mr) * 6144 + 5 * 1024) + F.lane;
#pragma unroll
            for (int j = 0; j < 4; ++j) g2c[j] = gq[64 * j]; }
        Row r; row_load_bf16(r, xres + (size_t)row * D, F.lane);
        row_add_moe(F, r, row, g2c, F.lane);
        const float rs = row_rms_scale(r, NORM_EPS);
#pragma unroll
        for (int j = 0; j < 4; ++j) r.v[j] = r.v[j] * rs * fg[j];
        row_store(r, (float*)(F.out + (size_t)row * D), F.lane);
    }
}

__device__ __forceinline__ void phase_f(Frame& F, int l, int Tm) {
    const int gw = F.vcu * NWAVES + F.wave, NGW = F.G * NWAVES;
    LAS float* rwt = (LAS float*)F.lds;
    LAS unsigned* tab = (LAS unsigned*)(F.lds + RC_OFF);
    LAS float* LG = (LAS float*)(F.lds + RC_OFF + 2560);
    for (int i = F.tid; i < 16 * 1024; i += NTHREADS) rwt[(i & 15) * 1024 + (i >> 4)] = GIN(F, I_RW)[i];
    if (F.tid < 16) F.MISC[64 + F.tid] = 0u;
    __syncthreads();
    const float* mods = (const float*)(F.ws + WS_MODS);
    const bf16* xres = (const bf16*)(F.ws + WS_XRES); bf16* H = (bf16*)(F.ws + WS_H);
    const int ex_l = ((F.lane >> 5) & 1) * 8 + ((F.lane >> 4) & 1) * 4 + ((F.lane >> 3) & 1) * 2 + ((F.lane >> 2) & 1);
    const int per = (Tm + NGW - 1) / NGW, r0 = gw * per, nr = r0 >= Tm ? 0 : (Tm - r0 < per ? Tm - r0 : per);
    int mr_c = -1; ModTab mt;
#pragma unroll
    for (int j = 0; j < 4; ++j) { float z_ = 0.f; asm volatile("" : "+v"(z_)); mt.gs[j] = (f32x4){z_, z_, z_, z_}; mt.sh[j] = mt.gs[j]; }
#pragma unroll 1
    for (int k = 0; k < nr; k += 2) {
        const bool two = k + 1 < nr; const int rowa = r0 + k, rowb = two ? rowa + 1 : rowa;
        Row ra, rb2; row_load_bf16(ra, xres + (size_t)rowa * D, F.lane); row_load_bf16(rb2, xres + (size_t)rowb * D, F.lane);
        { const int mr = rowa < TL ? (rowa >> 11) : 16; const float rs = row_rms_scale(ra, NORM_EPS);
          if (mr != mr_c) { mr_c = mr; const float* m = mods + ((size_t)l * 17 + mr) * 6144; modtab_load(mt, GIN(F, I_N2G) + l * D, m + 4 * 1024, m + 3 * 1024, F.lane); }
          row_modulate_t(ra, rs, mt);
          row_store_fp8(ra, (unsigned char*)H + (size_t)rowa * D, F8_SX, F.lane); }
        { const int mr = rowb < TL ? (rowb >> 11) : 16; const float rs = row_rms_scale(rb2, NORM_EPS);
          if (mr != mr_c) { mr_c = mr; const float* m = mods + ((size_t)l * 17 + mr) * 6144; modtab_load(mt, GIN(F, I_N2G) + l * D, m + 4 * 1024, m + 3 * 1024, F.lane); }
          row_modulate_t(rb2, rs, mt);
          row_store_fp8(rb2, (unsigned char*)H + (size_t)rowb * D, F8_SX, F.lane); }
        float pa[16], pb[16];
#pragma unroll
        for (int e = 0; e < 16; ++e) { pa[e] = 0.f; pb[e] = 0.f; }
#pragma unroll
        for (int j = 0; j < 4; ++j)
#pragma unroll
            for (int eh = 0; eh < 2; ++eh) { f32x4 ww[8];
#pragma unroll
                for (int e = 0; e < 8; ++e) ww[e] = ((const LAS f32x4*)(rwt + (8 * eh + e) * 1024))[64 * j + F.lane];
#pragma unroll
                for (int e = 0; e < 8; ++e) {
                    pa[8 * eh + e] = fmaf(ra.v[j].w, ww[e].w, fmaf(ra.v[j].z, ww[e].z, fmaf(ra.v[j].y, ww[e].y, fmaf(ra.v[j].x, ww[e].x, pa[8 * eh + e]))));
                    pb[8 * eh + e] = fmaf(rb2.v[j].w, ww[e].w, fmaf(rb2.v[j].z, ww[e].z, fmaf(rb2.v[j].y, ww[e].y, fmaf(rb2.v[j].x, ww[e].x, pb[8 * eh + e])))); }
#pragma unroll
                for (int e = 0; e < 8; ++e) asm volatile("" : "+v"(pa[8 * eh + e]), "+v"(pb[8 * eh + e]));
            }
#pragma unroll
        for (int h2 = 0; h2 < 2; ++h2) {
            float p[16];
#pragma unroll
            for (int e = 0; e < 16; ++e) p[e] = h2 ? pb[e] : pa[e];
            float q8[8], q4[4], q2[2], q1;
            { const bool hi = (F.lane & 32) != 0;
#pragma unroll
              for (int e = 0; e < 8; ++e) { const float keep = hi ? p[e + 8] : p[e], send = hi ? p[e] : p[e + 8]; q8[e] = keep + other_half(send, hi); } }
            { const bool hi = (F.lane & 16) != 0;
#pragma unroll
              for (int e = 0; e < 4; ++e) { const float keep = hi ? q8[e + 4] : q8[e], send = hi ? q8[e] : q8[e + 4]; q4[e] = keep + xor_lane<16>(send); } }
            { const bool hi = (F.lane & 8) != 0;
#pragma unroll
              for (int e = 0; e < 2; ++e) { const float keep = hi ? q4[e + 2] : q4[e], send = hi ? q4[e] : q4[e + 2]; q2[e] = keep + xor_lane<8>(send); } }
            { const bool hi = (F.lane & 4) != 0; const float keep = hi ? q2[1] : q2[0], send = hi ? q2[0] : q2[1]; q1 = keep + xor_lane<4>(send); }
            q1 += xor_lane<2>(q1); q1 += xor_lane<1>(q1);
            if ((F.lane & 3) == 0 && (h2 == 0 || two)) LG[(F.wave * 20 + k + h2) * 16 + ex_l] = q1;
        }
    }
    LDS_WAIT();
    if (F.lane < nr) {
        float aff[16], sel[16];
#pragma unroll
        for (int e4 = 0; e4 < 4; ++e4) { const f32x4 lg = *(const LAS f32x4*)(LG + (F.wave * 20 + F.lane) * 16 + 4 * e4); const f32x4 rb = *(const f32x4*)(GIN(F, I_RB) + 4 * e4);
#pragma unroll
            for (int k = 0; k < 4; ++k) { aff[4 * e4 + k] = 1.0f / (1.0f + expf(-lg[k])); sel[4 * e4 + k] = aff[4 * e4 + k] + rb[k]; } }
        float gs4[4];
#pragma unroll
        for (int g = 0; g < 4; ++g) { const float a = sel[4 * g], b = sel[4 * g + 1], c = sel[4 * g + 2], d = sel[4 * g + 3];
            gs4[g] = fmaxf(fmaxf(fmaxf(a + b, a + c), fmaxf(a + d, b + c)), fmaxf(b + d, c + d)); }
        int gbest = 0; float gsb = gs4[0];
#pragma unroll
        for (int g = 1; g < 4; ++g) { const bool c = gs4[g] > gsb; gsb = c ? gs4[g] : gsb; gbest = c ? g : gbest; }
        float cs[4], ca[4];
#pragma unroll
        for (int k = 0; k < 4; ++k) { cs[k] = gbest == 0 ? sel[k] : (gbest == 1 ? sel[4 + k] : (gbest == 2 ? sel[8 + k] : sel[12 + k]));
                                      ca[k] = gbest == 0 ? aff[k] : (gbest == 1 ? aff[4 + k] : (gbest == 2 ? aff[8 + k] : aff[12 + k])); }
        int k0 = 0; float s0 = cs[0], a0 = ca[0];
#pragma unroll
        for (int k = 1; k < 4; ++k) { const bool c = cs[k] > s0; s0 = c ? cs[k] : s0; a0 = c ? ca[k] : a0; k0 = c ? k : k0; }
        float neg_ = -1e30f; asm volatile("" : "+v"(neg_));
        int k1 = -1; float s1 = neg_, a1 = 0.f;
#pragma unroll
        for (int k = 0; k < 4; ++k) { const bool c = (k != k0) && (k1 < 0 || cs[k] > s1); s1 = c ? cs[k] : s1; a1 = c ? ca[k] : a1; k1 = c ? k : k1; }
        const int e0 = 4 * gbest + k0, e1 = 4 * gbest + k1;
        const float wn = 1.0f / (a0 + a1);
        const unsigned p0 = atomicAdd((unsigned*)&F.MISC[64 + e0], 1u), p1 = atomicAdd((unsigned*)&F.MISC[64 + e1], 1u);
        LAS unsigned* t = tab + (F.wave * 20 + F.lane) * 4; t[0] = ((unsigned)e0 << 24) | p0; t[1] = ((unsigned)e1 << 24) | p1; t[2] = __builtin_bit_cast(unsigned, a0 * wn); t[3] = __builtin_bit_cast(unsigned, a1 * wn);
    }
    __syncthreads();
    unsigned* cnt = (unsigned*)(F.ws + WS_CTL) + CW_CNT + l * 64;
    if (F.tid < 16) { const unsigned n = F.MISC[64 + F.tid]; F.MISC[80 + F.tid] = n ? __hip_atomic_fetch_add(cnt + F.tid, n, __ATOMIC_RELAXED, __HIP_MEMORY_SCOPE_AGENT) : 0u; }
    __syncthreads();
    unsigned* ti = (unsigned*)(F.ws + WS_TOKINFO); float* tw = (float*)(F.ws + WS_TOKW); int* list = (int*)(F.ws + WS_LIST);
    if (F.lane < nr) { const int row = r0 + F.lane; const LAS unsigned* t = tab + (F.wave * 20 + F.lane) * 4;
#pragma unroll
        for (int k = 0; k < 2; ++k) { const unsigned e = t[k] >> 24, pos = (t[k] & 0xffffffu) + F.MISC[80 + e];
            ti[2 * row + k] = (e << 24) | pos; tw[2 * row + k] = __builtin_bit_cast(float, t[2 + k]); list[(size_t)e * T + pos] = row; } }
}

__device__ __forceinline__ void fill_rowcache(Frame& F, const pg8::MoeOrder& S) {
    LAS int* rc = (LAS int*)(F.lds + RC_OFF); const int* list = (const int*)(F.ws + WS_LIST);
    if (F.tid < 256) {
        pg8::Unit u; u.pm = 0; u.pn = 0; u.e = 0; u.li = 0; int v[16]; bool ok[16];
#pragma unroll
        for (int i = 0; i < 16; ++i) { const bool has = S.next(i, u); const int local = (u.pm - (int)F.MISC[32 + u.e]) * 256 + F.tid;
            const bool in = has && local < (int)F.MISC[96 + u.e]; v[i] = in ? list[(size_t)u.e * T + local] : 0; ok[i] = has; }
#pragma unroll
        for (int i = 0; i < 16; ++i) if (ok[i]) rc[i * 256 + F.tid] = v[i];
    }
    __syncthreads();
}

__device__ __forceinline__ unsigned pk4_u8(float a, float b, float c, float d) { unsigned r = 0u;
    r = __builtin_amdgcn_cvt_pk_u8_f32(a, 0, r); r = __builtin_amdgcn_cvt_pk_u8_f32(b, 1, r); r = __builtin_amdgcn_cvt_pk_u8_f32(c, 2, r); r = __builtin_amdgcn_cvt_pk_u8_f32(d, 3, r); return r; }
struct EpiProj {
    static constexpr bool PERM = false; static constexpr bool WIDE = true;
    bf16* P; const f32x2* rope;
    __device__ __forceinline__ void operator()(const f32x4 (&acc)[2][2][4][2], const pg8::Unit& u, int wr, int wc, int fr, int fq) const {
        const int type = u.pn < 2 ? 0 : (u.pn < 4 ? 1 : (u.pn < 6 ? 2 : (u.pn < 8 ? 0 : 3)));
        const bool dorope = (type == 1 || type == 2) && u.pm < TL / 256;
        if (type == 3) {
#pragma unroll
            for (int ai = 0; ai < 2; ++ai)
#pragma unroll
                for (int m = 0; m < 4; ++m) { const int row = u.pm * 256 + ai * 128 + wr * 64 + m * 16 + fr;
                    unsigned X[2][2];
#pragma unroll
                    for (int bj = 0; bj < 2; ++bj)
#pragma unroll
                        for (int n = 0; n < 2; ++n) { const f32x4 v = acc[ai][bj][m][n];
                            X[bj][n] = pk4_u8(sigmoidf_(v[0]) * 255.0f, sigmoidf_(v[1]) * 255.0f, sigmoidf_(v[2]) * 255.0f, sigmoidf_(v[3]) * 255.0f); }
                    const auto z0 = __builtin_amdgcn_permlane16_swap(X[0][0], X[0][1], false, false); const auto z1 = __builtin_amdgcn_permlane16_swap(X[1][0], X[1][1], false, false);
                    const auto w0 = __builtin_amdgcn_permlane32_swap(z0[0], z1[0], false, false); const auto w1 = __builtin_amdgcn_permlane32_swap(z0[1], z1[1], false, false);
                    *(u32x4*)((unsigned char*)P + (size_t)row * (NCOL * 2) + NCOL + (u.pn - 8) * 256 + wc * 64 + 16 * fq) = (u32x4){w0[0], w1[0], w0[1], w1[1]}; }
            return; }
        int fql = fq; asm volatile("" : "+v"(fql));
        f32x4 csA[2][2], csB[4][2];
#pragma unroll
        for (int ai = 0; ai < 2; ++ai) { csA[ai][0] = (f32x4){1.f, 0.f, 1.f, 0.f}; csA[ai][1] = csA[ai][0]; }
#pragma unroll
        for (int m = 0; m < 4; ++m) { csB[m][0] = (f32x4){1.f, 0.f, 1.f, 0.f}; csB[m][1] = csB[m][0]; }
        if (dorope) {
#pragma unroll
            for (int ai = 0; ai < 2; ++ai) { const int pos = ((u.pm * 256 + ai * 128 + wr * 64) & (SEQ - 1)) >> 6; const f32x4* rp = (const f32x4*)(rope + pos * 16 + 4 * fql); csA[ai][0] = rp[0]; csA[ai][1] = rp[1]; }
            int frl = fr; asm volatile("" : "+v"(frl));
#pragma unroll
            for (int m = 0; m < 4; ++m) { const int pos = 16 * m + frl; const f32x4* rp = (const f32x4*)(rope + pos * 16 + 4 * fql); csB[m][0] = rp[0]; csB[m][1] = rp[1]; }
#pragma unroll
            for (int ai = 0; ai < 2; ++ai)
#pragma unroll
                for (int k = 0; k < 2; ++k) asm volatile("" : "+v"(csA[ai][k].x), "+v"(csA[ai][k].y), "+v"(csA[ai][k].z), "+v"(csA[ai][k].w));
#pragma unroll
            for (int m = 0; m < 4; ++m)
#pragma unroll
                for (int k = 0; k < 2; ++k) asm volatile("" : "+v"(csB[m][k].x), "+v"(csB[m][k].y), "+v"(csB[m][k].z), "+v"(csB[m][k].w));
        }
#pragma unroll
        for (int ai = 0; ai < 2; ++ai)
#pragma unroll
            for (int m = 0; m < 4; ++m) { const int row = u.pm * 256 + ai * 128 + wr * 64 + m * 16 + fr;
                bf16* rowp = P + (size_t)row * NCOL + u.pn * 256 + wc * 64 + (fql & 1) * 16 + (fql >> 1) * 8;
#pragma unroll
                for (int bj = 0; bj < 2; ++bj) { f32x4 v0 = acc[ai][bj][m][0], v1 = acc[ai][bj][m][1];
                    if (type == 1 || type == 2) { const f32x4 cs0 = bj ? csB[m][0] : csA[ai][0], cs1 = bj ? csB[m][1] : csA[ai][1];
                        const float co[4] = {cs0.x, cs0.z, cs1.x, cs1.z}, si[4] = {cs0.y, cs0.w, cs1.y, cs1.w};
                        f32x4 o0, o1;
#pragma unroll
                        for (int j = 0; j < 4; ++j) { o0[j] = v0[j] * co[j] - v1[j] * si[j]; o1[j] = v1[j] * co[j] + v0[j] * si[j]; }
                        v0 = o0; v1 = o1; if (type == 1) { v0 = v0 * QSCALE; v1 = v1 * QSCALE; } }
                    const unsigned a0 = pk2(v0[0], v0[1]), a1 = pk2(v0[2], v0[3]), b0 = pk2(v1[0], v1[1]), b1 = pk2(v1[2], v1[3]);
                    const auto r0 = __builtin_amdgcn_permlane16_swap(a0, b0, false, false); const auto r1 = __builtin_amdgcn_permlane16_swap(a1, b1, false, false);
                    *(u32x4*)(rowp + bj * 32) = (u32x4){r0[0], r1[0], r0[1], r1[1]}; }
                asm volatile("" ::: "memory"); }
    }
};
struct EpiGlu {
    static constexpr bool PERM = true; static constexpr bool WIDE = false;
    const bf16* P; bf16* MG;
    __device__ __forceinline__ void operator()(const f32x4 (&acc)[2][2][4][2], const pg8::Unit& u, int wr, int wc, int fr, int fq) const {
        const int col = u.pn * 128 + wc * 32 + 8 * fq;
        u32x2 gs[2][4];
#pragma unroll
        for (int ai = 0; ai < 2; ++ai)
#pragma unroll
            for (int m = 0; m < 4; ++m) { const int row = u.pm * 256 + ai * 128 + wr * 64 + m * 16 + fr;
                gs[ai][m] = *(const u32x2*)((const unsigned char*)P + (size_t)row * (NCOL * 2) + NCOL + col); }
#pragma unroll
        for (int ai = 0; ai < 2; ++ai)
#pragma unroll
            for (int m = 0; m < 4; ++m) asm volatile("" : "+v"(gs[ai][m].x), "+v"(gs[ai][m].y));
#pragma unroll
        for (int ai = 0; ai < 2; ++ai)
#pragma unroll
            for (int m = 0; m < 4; ++m) { const int row = u.pm * 256 + ai * 128 + wr * 64 + m * 16 + fr; const u32x2 gq = gs[ai][m];
                const float g[8] = {u8f(gq.x, 0), u8f(gq.x, 1), u8f(gq.x, 2), u8f(gq.x, 3), u8f(gq.y, 0), u8f(gq.y, 1), u8f(gq.y, 2), u8f(gq.y, 3)};
                f32x2 rr[4];
#pragma unroll
                for (int n = 0; n < 2; ++n)
#pragma unroll
                    for (int jp = 0; jp < 2; ++jp) { const f32x2 a = {acc[ai][0][m][n][2 * jp], acc[ai][0][m][n][2 * jp + 1]};
                        const f32x2 s = {sigmoidf_(acc[ai][1][m][n][2 * jp]), sigmoidf_(acc[ai][1][m][n][2 * jp + 1])}; const f32x2 gg = {g[4 * n + 2 * jp] * F8_SH, g[4 * n + 2 * jp + 1] * F8_SH};
                        rr[2 * n + jp] = a * s * gg; }
                *(u32x2*)((unsigned char*)MG + (size_t)row * D + col) = (u32x2){pk4_fp8(rr[0].x, rr[0].y, rr[1].x, rr[1].y), pk4_fp8(rr[2].x, rr[2].y, rr[3].x, rr[3].y)}; }
    }
};
struct EpiMerge {
    static constexpr bool PERM = true; static constexpr bool WIDE = true;
    const bf16* P; const bf16* MG; unsigned char* MG8;
    __device__ __forceinline__ void operator()(const f32x4 (&acc)[2][2][4][2], const pg8::Unit& u, int wr, int wc, int fr, int fq) const {
        const int scol = u.pn * 256 + wc * 64 + ((fq & 1) ? 32 + 8 * (fq - 1) : 8 * fq);
        u32x4 pk[4];
#pragma unroll
        for (int ai = 0; ai < 2; ++ai) {
            u32x2 ga[4][2]; u32x2 old[4][2];
#pragma unroll
            for (int m = 0; m < 4; ++m) { const int row = u.pm * 256 + ai * 128 + wr * 64 + m * 16 + fr;
#pragma unroll
                for (int bj = 0; bj < 2; ++bj) { const int col = u.pn * 256 + wc * 64 + bj * 32 + 8 * fq;
                    ga[m][bj] = *(const u32x2*)((const unsigned char*)P + (size_t)row * (NCOL * 2) + NCOL + 1024 + col); old[m][bj] = *(const u32x2*)((const unsigned char*)MG + (size_t)row * D + col); } }
#pragma unroll
            for (int m = 0; m < 4; ++m)
#pragma unroll
                for (int bj = 0; bj < 2; ++bj) asm volatile("" : "+v"(ga[m][bj].x), "+v"(ga[m][bj].y), "+v"(old[m][bj].x), "+v"(old[m][bj].y));
            if (ai == 1) {
#pragma unroll
                for (int m = 0; m < 4; ++m) { const int row = u.pm * 256 + wr * 64 + m * 16 + fr; *(u32x4*)(MG8 + (size_t)row * D + scol) = pk[m]; } }
#pragma unroll
            for (int m = 0; m < 4; ++m) { const int row = u.pm * 256 + ai * 128 + wr * 64 + m * 16 + fr;
                unsigned w[2][2];
#pragma unroll
                for (int bj = 0; bj < 2; ++bj) { const u32x2 gq = ga[m][bj]; const u32x2 oq = old[m][bj];
                    const float g[8] = {u8f(gq.x, 0), u8f(gq.x, 1), u8f(gq.x, 2), u8f(gq.x, 3), u8f(gq.y, 0), u8f(gq.y, 1), u8f(gq.y, 2), u8f(gq.y, 3)};
                    const f32x2 q01 = __builtin_amdgcn_cvt_pk_f32_fp8((int)oq.x, false), q23 = __builtin_amdgcn_cvt_pk_f32_fp8((int)oq.x, true), q45 = __builtin_amdgcn_cvt_pk_f32_fp8((int)oq.y, false), q67 = __builtin_amdgcn_cvt_pk_f32_fp8((int)oq.y, true);
                    const float q[8] = {q01.x, q01.y, q23.x, q23.y, q45.x, q45.y, q67.x, q67.y};
                    float o[8];
#pragma unroll
                    for (int n = 0; n < 2; ++n)
#pragma unroll
                        for (int j = 0; j < 4; ++j) o[4 * n + j] = acc[ai][bj][m][n][j] * (g[4 * n + j] * F8_SH) + q[4 * n + j];
                    w[bj][0] = pk4_fp8(o[0], o[1], o[2], o[3]); w[bj][1] = pk4_fp8(o[4], o[5], o[6], o[7]); }
                const auto r0 = __builtin_amdgcn_permlane16_swap(w[0][0], w[1][0], false, false); const auto r1 = __builtin_amdgcn_permlane16_swap(w[0][1], w[1][1], false, false);
                const u32x4 r = (u32x4){r0[0], r1[0], r0[1], r1[1]};
                if (ai == 0) pk[m] = r; else *(u32x4*)(MG8 + (size_t)row * D + scol) = r; }
        }
    }
};
struct EpiRes {
    static constexpr bool PERM = true; static constexpr bool WIDE = false;
    bf16* X; const float* mods_l;
    __device__ __forceinline__ void operator()(const f32x4 (&acc)[2][2][4][2], const pg8::Unit& u, int wr, int wc, int fr, int fq) const {
        const int mr = u.pm < TL / 256 ? (u.pm >> 3) : 16; const float* g1 = mods_l + (size_t)mr * 6144 + 2 * 1024;
        const int col0 = u.pn * 256 + wc * 32 + 8 * fq;
        f32x4 gv[2][2];
#pragma unroll
        for (int bj = 0; bj < 2; ++bj)
#pragma unroll
            for (int n = 0; n < 2; ++n) gv[bj][n] = *(const f32x4*)(g1 + col0 + bj * 128 + n * 4);
        u32x4 pk[4][2];
#pragma unroll
        for (int ai = 0; ai < 2; ++ai) {
            u32x4 old[4][2];
#pragma unroll
            for (int m = 0; m < 4; ++m) { const int row = u.pm * 256 + ai * 128 + wr * 64 + m * 16 + fr; const bf16* rowp = X + (size_t)row * D + col0;
#pragma unroll
                for (int bj = 0; bj < 2; ++bj) old[m][bj] = *(const u32x4*)(rowp + bj * 128); }
#pragma unroll
            for (int m = 0; m < 4; ++m)
#pragma unroll
                for (int bj = 0; bj < 2; ++bj) asm volatile("" : "+v"(old[m][bj].x), "+v"(old[m][bj].y), "+v"(old[m][bj].z), "+v"(old[m][bj].w));
            if (ai == 1) {
#pragma unroll
                for (int m = 0; m < 4; ++m) { const int row = u.pm * 256 + wr * 64 + m * 16 + fr; bf16* rowp = X + (size_t)row * D + col0;
#pragma unroll
                    for (int bj = 0; bj < 2; ++bj) *(u32x4*)(rowp + bj * 128) = pk[m][bj]; } }
#pragma unroll
            for (int m = 0; m < 4; ++m) { const int row = u.pm * 256 + ai * 128 + wr * 64 + m * 16 + fr; bf16* rowp = X + (size_t)row * D + col0;
#pragma unroll
                for (int bj = 0; bj < 2; ++bj) { const u32x4 o = old[m][bj];
                    const f32x4 x0 = (f32x4){bflo(o.x), bfhi(o.x), bflo(o.y), bfhi(o.y)} + gv[bj][0] * acc[ai][bj][m][0];
                    const f32x4 x1 = (f32x4){bflo(o.z), bfhi(o.z), bflo(o.w), bfhi(o.w)} + gv[bj][1] * acc[ai][bj][m][1];
                    const u32x4 r = (u32x4){pk2(x0[0], x0[1]), pk2(x0[2], x0[3]), pk2(x1[0], x1[1]), pk2(x1[2], x1[3])};
                    if (ai == 0) pk[m][bj] = r; else *(u32x4*)(rowp + bj * 128) = r; } }
        }
    }
};
struct EpiSwiglu {
    static constexpr bool PERM = true; static constexpr bool WIDE = false;
    bf16* HID;
    __device__ __forceinline__ void operator()(const f32x4 (&acc)[2][2][4][2], const pg8::Unit& u, int wr, int wc, int fr, int fq) const {
#pragma unroll
        for (int ai = 0; ai < 2; ++ai)
#pragma unroll
            for (int m = 0; m < 4; ++m) { const size_t row = (size_t)u.pm * 256 + ai * 128 + wr * 64 + m * 16 + fr; const int col = u.pn * 128 + wc * 32 + 8 * fq;
                float o[8];
#pragma unroll
                for (int n = 0; n < 2; ++n)
#pragma unroll
                    for (int j = 0; j < 4; ++j) { const float a = acc[ai][0][m][n][j]; o[4 * n + j] = a * sigmoidf_(a) * acc[ai][1][m][n][j] * F8_SH; }
                *(u32x2*)((unsigned char*)HID + row * D + col) = (u32x2){pk4_fp8(o[0], o[1], o[2], o[3]), pk4_fp8(o[4], o[5], o[6], o[7])}; }
    }
};
struct EpiPlain {
    static constexpr bool PERM = true; static constexpr bool WIDE = true;
    unsigned char* O;
    __device__ __forceinline__ void operator()(const f32x4 (&acc)[2][2][4][2], const pg8::Unit& u, int wr, int wc, int fr, int fq) const {
        const int col = u.pn * 256 + wc * 64 + ((fq & 1) ? 32 + 8 * (fq - 1) : 8 * fq);
#pragma unroll
        for (int ai = 0; ai < 2; ++ai)
#pragma unroll
            for (int m = 0; m < 4; ++m) { const size_t row = (size_t)u.pm * 256 + ai * 128 + wr * 64 + m * 16 + fr;
                unsigned w[2][2];
#pragma unroll
                for (int bj = 0; bj < 2; ++bj)
#pragma unroll
                    for (int n = 0; n < 2; ++n) { const f32x4 v = acc[ai][bj][m][n]; w[bj][n] = pk4_fp8(v[0] * F8_SY, v[1] * F8_SY, v[2] * F8_SY, v[3] * F8_SY); }
                const auto r0 = __builtin_amdgcn_permlane16_swap(w[0][0], w[1][0], false, false); const auto r1 = __builtin_amdgcn_permlane16_swap(w[0][1], w[1][1], false, false);
                *(u32x4*)(O + row * D + col) = (u32x4){r0[0], r1[0], r0[1], r1[1]}; }
    }
};

constexpr int S5_HS = 136, S5_WAVE_BYTES = 2 * 32 * S5_HS * 2, S5_YL_OFF = 4 * S5_WAVE_BYTES, S5_YL_BYTES = 8192, S5_CONV_OFF = S5_YL_OFF + 4 * S5_YL_BYTES;
typedef float f32x16s __attribute__((ext_vector_type(16)));
__device__ __forceinline__ void s5_consts(Frame& F, int l, int dir, int g, int lane, float& are, float& aim, bf16x8 (&Bop)[4], bf16x8 (&Cop)[4]) {
    const int fr = lane & 15, fq = lane >> 4, r = lane & 31, hh = lane >> 5;
    const size_t pbase = ((size_t)(l * 2 + dir) * NG + g) * 64;
    const float dt = expf(GIN(F, I_LDT)[(l * 2 + dir) * NG + g]);
    { const float lr = GIN(F, I_LRE)[pbase + lane], li = GIN(F, I_LIM)[pbase + lane]; const float dec = expf(lr * dt); are = dec * cosf(li * dt); aim = dec * sinf(li * dt); }
#pragma unroll
    for (int tl = 0; tl < 4; ++tl) { const int p = r + 32 * (tl & 1); const bool isim = tl >= 2;
        const float lr = GIN(F, I_LRE)[pbase + p], li = GIN(F, I_LIM)[pbase + p]; const float dec = expf(lr * dt); const float ar = dec * cosf(li * dt), ai = dec * sinf(li * dt);
        const float den = lr * lr + li * li, nr = ar - 1.0f, ni = ai; const float cr = (nr * lr + ni * li) / den, ci = (ni * lr - nr * li) / den;
        const float* br = GIN(F, I_BRE) + (pbase + p) * 16 + 8 * hh; const float* bi = GIN(F, I_BIM) + (pbase + p) * 16 + 8 * hh; bf16x8 v;
#pragma unroll
        for (int j = 0; j < 8; ++j) { const float x = isim ? (cr * bi[j] + ci * br[j]) : (cr * br[j] - ci * bi[j]); v[j] = (short)f2bf(x); }
        Bop[tl] = v; }
#pragma unroll
    for (int ks = 0; ks < 4; ++ks) { const size_t cb = (((size_t)(l * 2 + dir) * NG + g) * 16 + fr) * 64 + 16 * ks + 4 * fq; bf16x8 v;
#pragma unroll
        for (int j = 0; j < 8; ++j) v[j] = (short)f2bf((j & 1) ? -GIN(F, I_CIM)[cb + (j >> 1)] : GIN(F, I_CRE)[cb + (j >> 1)]);
        Cop[ks] = v; }
}
__device__ __forceinline__ void p0_s5tab(Frame& F) {
    if (F.wave != 0) return;
    for (int e = blockIdx.x; e < DEPTH * 2 * NG; e += F.G) { const int l = e / (2 * NG), dir = (e / NG) & 1, g = e % NG;
        float are, aim; bf16x8 Bop[4], Cop[4]; s5_consts(F, l, dir, g, F.lane, are, aim, Bop, Cop);
        unsigned char* sc = (unsigned char*)(F.ws + WS_S5C) + (size_t)e * S5C_BYTES;
        *(f32x2*)(sc + F.lane * 8) = (f32x2){are, aim};
#pragma unroll
        for (int k = 0; k < 4; ++k) { *(bf16x8*)(sc + 512 + (k * 64 + F.lane) * 16) = Bop[k]; *(bf16x8*)(sc + 4608 + (k * 64 + F.lane) * 16) = Cop[k]; } }
}
__device__ __forceinline__ void s5_phase(Frame& F, int l) {
    if (F.wave >= 4) return;
    const int lane = F.lane, fr = lane & 15, fq = lane >> 4, r = lane & 31, hh = lane >> 5;
    const int blk = F.vcu;
    const int dir = F.wave & 1, g = 2 * (blk & 15) + (F.wave >> 1), b = blk >> 4;
    LAS bf16* HH = (LAS bf16*)(F.lds + F.wave * S5_WAVE_BYTES);
    float are, aim; bf16x8 Bop[4], Cop[4];
    { const unsigned char* sc = (const unsigned char*)(F.ws + WS_S5C) + (size_t)((l * 2 + dir) * NG + g) * S5C_BYTES;
      const f32x2 a = *(const f32x2*)(sc + lane * 8); are = a.x; aim = a.y;
#pragma unroll
      for (int k = 0; k < 4; ++k) { Bop[k] = *(const bf16x8*)(sc + 512 + (k * 64 + lane) * 16); Cop[k] = *(const bf16x8*)(sc + 4608 + (k * 64 + lane) * 16); } }
    const bf16* P = (const bf16*)(F.ws + WS_P); bf16* Y = (bf16*)(F.ws + (dir ? WS_YB : WS_YF));
    float hre = 0.f, him = 0.f;
#define S5_ROW0(tk) ((tk) < 8 ? TL + b * LC + (dir ? (LC - 32 * ((tk) + 1)) : 32 * (tk)) : b * SEQ + (dir ? (SEQ - 32 * ((tk) - 8 + 1)) : 32 * ((tk) - 8)))
    LAS bf16* YL = (LAS bf16*)(F.lds + S5_YL_OFF + F.wave * S5_YL_BYTES);
#define S5_READOUT(tkp) do { const LAS bf16* Hb = HH + ((tkp) & 1) * (32 * S5_HS); bf16x8 Hop[2][4]; \
        _Pragma("unroll") for (int st = 0; st < 2; ++st) _Pragma("unroll") for (int ks = 0; ks < 4; ++ks) Hop[st][ks] = *(const LAS bf16x8*)(Hb + (16 * st + fr) * S5_HS + 32 * ks + 8 * fq); \
        _Pragma("unroll") for (int st = 0; st < 2; ++st) { f32x4 a = {0.f, 0.f, 0.f, 0.f}; \
            _Pragma("unroll") for (int ks = 0; ks < 4; ++ks) a = __builtin_amdgcn_mfma_f32_16x16x32_bf16(Hop[st][ks], Cop[ks], a, 0, 0, 0); \
            _Pragma("unroll") for (int j = 0; j < 4; ++j) YL[(((tkp) & 7) * 32 + 16 * st + 4 * fq + j) * 16 + fr] = (bf16)f2bf(a[j]); } } while (0)
#define S5_FLUSH(g8) do { LDS_WAIT(); const int first = (g8) == 0 ? TL + b * LC + (dir ? LC - 1 : 0) : b * SEQ + (dir ? SEQ - 1 - 256 * ((g8) - 1) : 256 * ((g8) - 1)); \
        _Pragma("unroll") for (int it = 0; it < 8; ++it) { const int i = it * 32 + (lane >> 1); const u32x4 w = *(const LAS u32x4*)(YL + i * 16 + 8 * (lane & 1)); \
            *(u32x4*)(Y + (size_t)(dir ? first - i : first + i) * 512 + 16 * g + 8 * (lane & 1)) = w; } \
        LDS_WAIT(); } while (0)
    bf16x8 Ucur = *(const bf16x8*)(P + (size_t)(S5_ROW0(0) + (dir ? 31 - r : r)) * NCOL + CU_ + 16 * g + 8 * hh);
#pragma unroll 1
    for (int tk = 0; tk < 72; ++tk) {
        const int tkn = tk < 71 ? tk + 1 : 71;
        const bf16x8 Unext = *(const bf16x8*)(P + (size_t)(S5_ROW0(tkn) + (dir ? 31 - r : r)) * NCOL + CU_ + 16 * g + 8 * hh);
        f32x16s acc[4];
#pragma unroll
        for (int tl = 0; tl < 4; ++tl) {
#pragma unroll
            for (int i = 0; i < 16; ++i) acc[tl][i] = 0.f;
            acc[tl] = __builtin_amdgcn_mfma_f32_32x32x16_bf16(Ucur, Bop[tl], acc[tl], 0, 0, 0); }
        if (tk > 0) { S5_READOUT(tk - 1); if ((tk & 7) == 0) S5_FLUSH((tk >> 3) - 1); }
        float bre[32], bim[32];
#pragma unroll
        for (int i = 0; i < 16; ++i) { const int t0 = (i & 3) + 8 * (i >> 2);
            { const float xa = acc[0][i], xb = acc[1][i]; auto rr = __builtin_amdgcn_permlane32_swap(__float_as_uint(xa), __float_as_uint(xb), false, false);
              bre[t0] = __uint_as_float(rr[0]); bre[t0 + 4] = __uint_as_float(rr[1]); }
            { const float xa = acc[2][i], xb = acc[3][i]; auto rr = __builtin_amdgcn_permlane32_swap(__float_as_uint(xa), __float_as_uint(xb), false, false);
              bim[t0] = __uint_as_float(rr[0]); bim[t0 + 4] = __uint_as_float(rr[1]); } }
        LAS bf16* Hw = HH + (tk & 1) * (32 * S5_HS);
#pragma unroll
        for (int t = 0; t < 32; ++t) { const float nre = fmaf(-aim, him, fmaf(are, hre, bre[t])), nim = fmaf(aim, hre, fmaf(are, him, bim[t])); hre = nre; him = nim;
            *(LAS unsigned*)(Hw + t * S5_HS + 2 * lane) = pg8::cvt_pk_bf16(hre, him); }
        LDS_WAIT();
        Ucur = Unext;
    }
    S5_READOUT(71);
    S5_FLUSH(8);
#undef S5_READOUT
#undef S5_FLUSH
#undef S5_ROW0
}
__device__ __forceinline__ float gelu_tanh(float x) { const float z = 0.7978845608028654f * (x + 0.044715f * x * x * x); const float e = __builtin_amdgcn_exp2f(2.8853900817779268f * z); const float th = 1.0f - 2.0f * __builtin_amdgcn_rcpf(e + 1.0f); return 0.5f * x * (1.0f + th); }
__device__ __forceinline__ void s5_finish(Frame& F, int l, bool ctx_rows) {
    const bf16* P = (const bf16*)(F.ws + WS_P); const bf16* YF = (const bf16*)(F.ws + WS_YF); const bf16* YB = (const bf16*)(F.ws + WS_YB); unsigned char* YG = (unsigned char*)(F.ws + WS_YG);
    const int blk = F.vcu, b = blk >> 4, c0 = 32 * (blk & 15);
    const float* dsk = GIN(F, I_SD) + l * 512;
    const int nrows = SEQ + (ctx_rows ? LC : 0);
    const int c16 = c0 + (F.tid & 1) * 16;
    f32x4 dd[4];
#pragma unroll
    for (int q = 0; q < 4; ++q) dd[q] = *(const f32x4*)(dsk + c16 + 4 * q);
#pragma unroll 1
    for (int rr = F.tid >> 1; rr < nrows; rr += NTHREADS / 2) { const size_t row = rr < SEQ ? (size_t)b * SEQ + rr : (size_t)TL + (size_t)b * LC + (rr - SEQ);
        u32x4 u[2], a[2], bb[2];
#pragma unroll
        for (int h = 0; h < 2; ++h) { u[h] = *(const u32x4*)(P + row * NCOL + CU_ + c16 + 8 * h); a[h] = *(const u32x4*)(YF + row * 512 + c16 + 8 * h); bb[h] = *(const u32x4*)(YB + row * 512 + c16 + 8 * h); }
        unsigned o[4];
#pragma unroll
        for (int h = 0; h < 2; ++h) { const f32x4 d0 = dd[2 * h], d1 = dd[2 * h + 1]; float y[8];
            y[0] = d0.x * bflo(u[h].x) + bflo(a[h].x) + bflo(bb[h].x); y[1] = d0.y * bfhi(u[h].x) + bfhi(a[h].x) + bfhi(bb[h].x);
            y[2] = d0.z * bflo(u[h].y) + bflo(a[h].y) + bflo(bb[h].y); y[3] = d0.w * bfhi(u[h].y) + bfhi(a[h].y) + bfhi(bb[h].y);
            y[4] = d1.x * bflo(u[h].z) + bflo(a[h].z) + bflo(bb[h].z); y[5] = d1.y * bfhi(u[h].z) + bfhi(a[h].z) + bfhi(bb[h].z);
            y[6] = d1.z * bflo(u[h].w) + bflo(a[h].w) + bflo(bb[h].w); y[7] = d1.w * bfhi(u[h].w) + bfhi(a[h].w) + bfhi(bb[h].w);
#pragma unroll
            for (int j = 0; j < 8; ++j) y[j] = gelu_tanh(y[j]) * F8_SH;
            o[2 * h] = pk4_fp8(y[0], y[1], y[2], y[3]); o[2 * h + 1] = pk4_fp8(y[4], y[5], y[6], y[7]); }
        *(u32x4*)(YG + row * 512 + c16) = (u32x4){o[0], o[1], o[2], o[3]}; }
}

typedef float f32x16 __attribute__((ext_vector_type(16)));
typedef short s16x4 __attribute__((ext_vector_type(4)));
constexpr int AT_BUF = 32768, AT_VOFF = 16384;
constexpr float AT_THR = 8.0f;
__device__ __forceinline__ unsigned cvtpk(float lo, float hi) { unsigned r; asm("v_cvt_pk_bf16_f32 %0, %1, %2" : "=v"(r) : "v"(lo), "v"(hi)); return r; }
template <int OFF> __device__ __forceinline__ s16x4 tr_read(unsigned a) { s16x4 r; asm volatile("ds_read_b64_tr_b16 %0, %1 offset:%2" : "=&v"(r) : "v"(a), "i"(OFF) : "memory"); return r; }
__device__ __forceinline__ void att_issue(const bf16* P, int krow, int h, LAS unsigned char* buf, int wave, int lane) {
#pragma unroll
    for (int j = 0; j < 2; ++j) { const int n = 2 * wave + j; const int img = n >> 3, rg = (n >> 1) & 3, cgp = n & 1;
        const int sub = lane >> 5, rr = (lane & 31) >> 2, pos = lane & 3; const int row = 8 * rg + rr, ch = 4 * (2 * cgp + sub) + (pos ^ ((row >> 2) & 3));
        const bf16* src = P + (size_t)(krow + 32 * img + row) * NCOL + h * 128 + 8 * ch;
        LAS unsigned char* dst = buf + 8192 * img + 2048 * rg + 1024 * cgp;
        __builtin_amdgcn_global_load_lds((const unsigned*)(src + CK), (LAS unsigned*)dst, 16, 0, 0);
        __builtin_amdgcn_global_load_lds((const unsigned*)(src + CV), (LAS unsigned*)(dst + AT_VOFF), 16, 0, 0); }
}
template <int ST, int S2> __device__ __forceinline__ void att_pv(f32x16 (&O)[2][4], unsigned va0, unsigned va1, const bf16x8 (&Pop)[2][2]) {
    constexpr int OFF = AT_VOFF + 8192 * ST + 4096 * S2;
    const s16x4 a0 = tr_read<OFF>(va0), b0 = tr_read<OFF>(va1), a1 = tr_read<OFF + 512>(va0), b1 = tr_read<OFF + 512>(va1);
    const s16x4 a2 = tr_read<OFF + 1024>(va0), b2 = tr_read<OFF + 1024>(va1), a3 = tr_read<OFF + 1536>(va0), b3 = tr_read<OFF + 1536>(va1);
    asm volatile("s_waitcnt lgkmcnt(0)" ::: "memory"); __builtin_amdgcn_sched_barrier(0);
#define AT_PK(L, H) (bf16x8){L[0], L[1], L[2], L[3], H[0], H[1], H[2], H[3]}
    const bf16x8 v0 = AT_PK(a0, b0), v1 = AT_PK(a1, b1), v2 = AT_PK(a2, b2), v3 = AT_PK(a3, b3);
#undef AT_PK
#pragma unroll
    for (int m = 0; m < 2; ++m) {
        O[m][0] = __builtin_amdgcn_mfma_f32_32x32x16_bf16(v0, Pop[m][S2], O[m][0], 0, 0, 0);
        O[m][1] = __builtin_amdgcn_mfma_f32_32x32x16_bf16(v1, Pop[m][S2], O[m][1], 0, 0, 0);
        O[m][2] = __builtin_amdgcn_mfma_f32_32x32x16_bf16(v2, Pop[m][S2], O[m][2], 0, 0, 0);
        O[m][3] = __builtin_amdgcn_mfma_f32_32x32x16_bf16(v3, Pop[m][S2], O[m][3], 0, 0, 0); }
}
template <int ST> __device__ __forceinline__ void att_sub(f32x16 (&O)[2][4], const bf16x8 (&Qop)[2][4], float (&mrun)[2], float (&lrun)[2], LAS unsigned char* kbuf, unsigned kb0, unsigned kb1, unsigned va0, unsigned va1, const bool SAFE) {
    bf16x8 Pop[2][2];
#pragma unroll
    for (int m = 0; m < 2; ++m) {
        f32x16 S;
#pragma unroll
        for (int i = 0; i < 16; ++i) S[i] = 0.f;
#pragma unroll
        for (int ks = 0; ks < 4; ++ks) { const int s = 4 * m + ks;
            const bf16x8 Kop = *(const LAS bf16x8*)(kbuf + 8192 * ST + ((s & 1) ? kb1 : kb0) + 512 * (s >> 1));
            S = __builtin_amdgcn_mfma_f32_32x32x16_bf16(Kop, Qop[m][ks], S, 0, 0, 0); }
        float rs = 0.f;
        if (SAFE) {
            float mx = S[0];
#pragma unroll
            for (int i = 1; i < 16; ++i) mx = fmaxf(mx, S[i]);
            { auto rr = __builtin_amdgcn_permlane32_swap(__float_as_uint(mx), __float_as_uint(mx), false, false); mx = fmaxf(__uint_as_float(rr[0]), __uint_as_float(rr[1])); }
            if (__any(mx > mrun[m] + AT_THR)) {
                const float mn = fmaxf(mrun[m], mx), alpha = __builtin_amdgcn_exp2f(mrun[m] - mn); mrun[m] = mn; lrun[m] *= alpha;
#pragma unroll
                for (int c = 0; c < 4; ++c) O[m][c] = O[m][c] * alpha; }
            const float mm = mrun[m];
#pragma unroll
            for (int i = 0; i < 16; ++i) { S[i] = __builtin_amdgcn_exp2f(S[i] - mm); rs += S[i]; }
        } else {
#pragma unroll
            for (int i = 0; i < 16; ++i) { S[i] = __builtin_amdgcn_exp2f(S[i]); rs += S[i]; }
        }
        lrun[m] += rs;
#pragma unroll
        for (int s2 = 0; s2 < 2; ++s2) { const u32x4 w = {cvtpk(S[8 * s2], S[8 * s2 + 1]), cvtpk(S[8 * s2 + 2], S[8 * s2 + 3]), cvtpk(S[8 * s2 + 4], S[8 * s2 + 5]), cvtpk(S[8 * s2 + 6], S[8 * s2 + 7])};
            Pop[m][s2] = __builtin_bit_cast(bf16x8, w); }
    }
    att_pv<ST, 0>(O, va0, va1, Pop);
    att_pv<ST, 1>(O, va0, va1, Pop);
}
__device__ __forceinline__ void att_loop(Frame& F, const bf16* P, int b, int h, int nkt, const bf16x8 (&Qop)[2][4], f32x16 (&O)[2][4], float (&lrun)[2], unsigned kb0, unsigned kb1, unsigned vb0, unsigned vb1, const bool SAFE) {
    const int lane = F.lane;
    __syncthreads();
    if (F.tid == 0 && !SAFE) F.MISC[120] = 0u;
    att_issue(P, TL + b * LC, h, F.lds, F.wave, lane);
    float zero_ = 0.f; asm volatile("" : "+v"(zero_));
#pragma unroll
    for (int m = 0; m < 2; ++m)
#pragma unroll
        for (int c = 0; c < 4; ++c)
#pragma unroll
            for (int i = 0; i < 16; ++i) O[m][c][i] = zero_;
    float neg_ = -1e30f; asm volatile("" : "+v"(neg_));
    float mrun[2] = {neg_, neg_}; lrun[0] = zero_; lrun[1] = zero_;
#pragma unroll 1
    for (int kt = 0; kt < nkt; ++kt) {
        asm volatile("s_waitcnt vmcnt(0)" ::: "memory");
        __syncthreads();
        if (kt + 1 < nkt) { const int k1 = kt + 1; const int krow = k1 < 4 ? TL + b * LC + 64 * k1 : b * SEQ + 64 * (k1 - 4);
            int lane_l = lane; asm volatile("" : "+v"(lane_l));
            att_issue(P, krow, h, F.lds + (k1 & 1) * AT_BUF, F.wave, lane_l); }
        LAS unsigned char* kbuf = F.lds + (kt & 1) * AT_BUF; const unsigned vo = (unsigned)(kt & 1) * AT_BUF;
        att_sub<0>(O, Qop, mrun, lrun, kbuf, kb0, kb1, vb0 + vo, vb1 + vo, SAFE);
        att_sub<1>(O, Qop, mrun, lrun, kbuf, kb0, kb1, vb0 + vo, vb1 + vo, SAFE);
    }
}
__device__ __forceinline__ void attn_unit(Frame& F, int l, int b, int h, int qt, bool isctx, float lam, float lam_init) {
    const int lane = F.lane, r = lane & 31, hh = lane >> 5;
    const bf16* P = (const bf16*)(F.ws + WS_P); bf16* ON = (bf16*)(F.ws + WS_ON);
    const int rowQ = (isctx ? TL + b * LC : b * SEQ + 256 * qt) + F.wave * 32 + r;
    const int nkt = isctx ? 4 : 36;
    const unsigned pr = (r & ~12u) | ((r & 4u) << 1) | ((r & 8u) >> 1);
    const unsigned kb0 = 2048u * (pr >> 3) + 64u * (pr & 7) + 16u * ((0u + hh) ^ ((pr >> 2) & 3)), kb1 = 2048u * (pr >> 3) + 64u * (pr & 7) + 16u * ((2u + hh) ^ ((pr >> 2) & 3));
    const unsigned q4 = (lane & 15) >> 2, p4 = lane & 3, blk = (lane >> 4) & 1;
    const unsigned ldsb = (unsigned)(size_t)F.lds;
    const unsigned vb0 = ldsb + 2048u * hh + 64u * (0u + q4) + 16u * ((2u * blk + (p4 >> 1)) ^ ((2u * hh + 0u) & 3)) + 8u * (p4 & 1);
    const unsigned vb1 = ldsb + 2048u * hh + 64u * (4u + q4) + 16u * ((2u * blk + (p4 >> 1)) ^ ((2u * hh + 1u) & 3)) + 8u * (p4 & 1);
    bf16x8 Qop[2][4];
#pragma unroll
    for (int m = 0; m < 2; ++m)
#pragma unroll
        for (int ks = 0; ks < 4; ++ks) Qop[m][ks] = *(const bf16x8*)(P + (size_t)rowQ * NCOL + CQ + h * 128 + m * 64 + 16 * ks + 8 * hh);
    f32x16 O[2][4]; float lrun[2];
    float l0, l1; bool safe = false;
#pragma unroll 1
    for (;;) {
        att_loop(F, P, b, h, nkt, Qop, O, lrun, kb0, kb1, vb0, vb1, safe);
        l0 = sum_xor32(lrun[0]); l1 = sum_xor32(lrun[1]);
        if (safe) break;
        const bool bad = !(l0 > 0x1p-100f && l0 < 0x1p100f && l1 > 0x1p-100f && l1 < 0x1p100f);
        if (__any(bad) && lane == 0) F.MISC[120] = 1u;
        __syncthreads();
        if (F.MISC[120] == 0u) break;
        safe = true; }
    const float c0 = 1.0f / l0, c1 = lam / l1; float ss = 0.f;
#pragma unroll
    for (int c = 0; c < 4; ++c)
#pragma unroll
        for (int i = 0; i < 16; ++i) { const float o = O[0][c][i] * c0 - O[1][c][i] * c1; O[0][c][i] = o; ss += o * o; }
    ss = sum_xor32(ss);
    const float rn = rsqrtf(ss * (1.0f / 128.0f) + SUBLN_EPS) * (1.0f - lam_init);
    const float* sg = GIN(F, I_SUBG) + l * 128; const float rn16 = rn * F8_SH;
    int l2 = lane; asm volatile("" : "+v"(l2));
    const int rowQo = (isctx ? TL + b * LC : b * SEQ + 256 * qt) + F.wave * 32 + (l2 & 31), hho = l2 >> 5;
    unsigned char* op = (unsigned char*)ON + (size_t)rowQo * 512 + h * 128 + 4 * hho;
#pragma unroll
    for (int c = 0; c < 4; ++c)
#pragma unroll
        for (int g4 = 0; g4 < 4; ++g4) { const f32x4 gg = *(const f32x4*)(sg + 32 * c + 8 * g4 + 4 * hho);
            *(unsigned*)(op + 32 * c + 8 * g4) = pk4_fp8(O[0][c][4 * g4] * rn16 * gg[0], O[0][c][4 * g4 + 1] * rn16 * gg[1], O[0][c][4 * g4 + 2] * rn16 * gg[2], O[0][c][4 * g4 + 3] * rn16 * gg[3]); }
}
__device__ __forceinline__ void attn_phase(Frame& F, int l, bool ctx_out) {
    const float lam_init = 0.8f - 0.6f * expf(-0.3f * (float)l);
    const float* al = GIN(F, I_ALAM) + l * 256;
    float d1 = 0.f, d2 = 0.f;
    for (int i = 0; i < 64; ++i) { d1 += al[i] * al[64 + i]; d2 += al[128 + i] * al[192 + i]; }
    const float lam = expf(d1) - expf(d2) + lam_init;
    const int nu = 512 + (ctx_out ? 64 : 0);
    for (int u = F.vcu; u < nu; u += F.G) {
        if (u < 512) { const int bh = u >> 3, qt = u & 7; attn_unit(F, l, bh >> 2, bh & 3, qt, false, lam, lam_init); }
        else { const int bh = u - 512; attn_unit(F, l, bh >> 2, bh & 3, 0, true, lam, lam_init); }
    }
    __syncthreads();
}

__global__ void __launch_bounds__(NTHREADS, 2) fwd_kernel(Args args) {
    extern __shared__ __attribute__((aligned(16))) unsigned char lds_raw[];
    Frame F;
    F.lds = (LAS unsigned char*)lds_raw; F.MISC = (volatile LAS unsigned*)(F.lds + MISC_OFF);
    F.tid = threadIdx.x; F.lane = F.tid & 63; F.wave = __builtin_amdgcn_readfirstlane(F.tid >> 6);
    F.G = gridDim.x; { const int bx = blockIdx.x; F.vcu = (F.G % 8 == 0) ? (bx % 8) * (F.G / 8) + bx / 8 : bx; }
    F.in = args.in; F.out = args.out; F.ws = args.ws;
    for (int u = F.tid; u < 256; u += NTHREADS) F.MISC[u] = 0u;
    __syncthreads();
    (void)xcd_barrier_post((unsigned*)(F.ws + WS_CTL) + CW_BAR, F.MISC + 8);
    const int wave0 = __builtin_amdgcn_readfirstlane(threadIdx.x >> 6);
#define RELAUNDER() do { unsigned z_ = 0u; asm volatile("" : "+v"(z_)); int l_ = (int)__builtin_amdgcn_mbcnt_hi(~0u, __builtin_amdgcn_mbcnt_lo(~0u, z_)); asm volatile("" : "+v"(l_)); int wv_ = wave0; asm volatile("" : "+s"(wv_)); F.lane = l_; F.wave = wv_; F.tid = wv_ * 64 + l_; \
    GAS unsigned char* w_ = args.ws; asm volatile("" : "+s"(w_)); F.ws = w_; } while (0)
#define GRID_BAR() do { RELAUNDER(); XcdBarrier b2_; GAS unsigned char* wb_ = args.ws; asm volatile("" : "+s"(wb_)); b2_.bar = (unsigned*)(wb_ + WS_CTL) + CW_BAR; unsigned x_ = xb_xcc_id(); asm volatile("" : "+s"(x_)); b2_.x = x_; b2_.st = F.MISC + 8; xcd_barrier(b2_, F.tid); } while (0)
    LAS unsigned char* lds = F.lds;
    const LAS int* rowcache = (const LAS int*)(lds + RC_OFF);
    const LAS int* segt = (const LAS int*)(lds + MISC_OFF + 32 * 4);
    const pg8::bf16_t* ws16 = (const pg8::bf16_t*)F.ws;

    p0_mods(F);
    __syncthreads();
    p0_s5tab(F);
    convert_weights(F, 0, F.wave, NWAVES, (LAS float*)(F.lds + F.wave * 16384));
    GRID_BAR();
#pragma unroll 1
    for (int l = 0; l < DEPTH; ++l) {
        const bool ctx_out = l < DEPTH - 1;
        const int Tm = ctx_out ? T : TL;
        const size_t wsel = (l & 1) ? WS_WALT : 0;
        RELAUNDER();
        if (l > 0) load_segt(F, l - 1);
        phase_a(F, l);
        GRID_BAR();
        RELAUNDER();
        { pg8::Gemm g{(const pg8::bf16_t*)(F.ws + WS_H), (const pg8::bf16_t*)(F.ws + wsel + WS_WIN), T, NCOL, D, F8_EX, F8_EW}; pg8::StaticOrder S; S.init(T, NCOL, F.G, (int)blockIdx.x);
          EpiProj E{(bf16*)(F.ws + WS_P), (const f32x2*)(F.ws + WS_ROPE)};
          pg8::gemm_phase<EpiProj, pg8::StaticOrder, false, true>(lds, g, S, E, rowcache, F.tid); }
        GRID_BAR();
        RELAUNDER();
        s5_phase(F, l);
        if (F.wave >= 4 && l + 1 < DEPTH) convert_weights(F, l + 1, F.wave - 4, 4, (LAS float*)(F.lds + S5_CONV_OFF + (F.wave - 4) * 8448));
        asm volatile("s_waitcnt vmcnt(0)" ::: "memory");
        __syncthreads();
        RELAUNDER();
        s5_finish(F, l, ctx_out);
        RELAUNDER();
        attn_phase(F, l, ctx_out);
        GRID_BAR();
        RELAUNDER();
        { pg8::Gemm g{(const pg8::bf16_t*)(F.ws + WS_YG), (const pg8::bf16_t*)(F.ws + wsel + WS_WGLU), Tm, 2048, 512, F8_EH, F8_EW}; pg8::StaticOrder S; S.init(Tm, 2048, F.G, (int)blockIdx.x);
          EpiGlu E{(const bf16*)(F.ws + WS_P), (bf16*)(F.ws + WS_MG)};
          pg8::gemm_phase<EpiGlu, pg8::StaticOrder, false, true>(lds, g, S, E, rowcache, F.tid); }
        GRID_BAR();
        RELAUNDER();
        { pg8::Gemm g{(const pg8::bf16_t*)(F.ws + WS_ON), (const pg8::bf16_t*)(F.ws + wsel + WS_WAO), Tm, 1024, 512, F8_EH, F8_EW}; pg8::StaticOrder S; S.init(Tm, 1024, F.G, (int)blockIdx.x);
          EpiMerge E{(const bf16*)(F.ws + WS_P), (const bf16*)(F.ws + WS_MG), (unsigned char*)(F.ws + WS_YF)};
          pg8::gemm_phase<EpiMerge, pg8::StaticOrder, false, true>(lds, g, S, E, rowcache, F.tid); }
        GRID_BAR();
        RELAUNDER();
        { pg8::Gemm g{(const pg8::bf16_t*)(F.ws + WS_YF), (const pg8::bf16_t*)(F.ws + wsel + WS_WO), Tm, 1024, 1024, F8_EH, F8_EW}; pg8::StaticOrder S; S.init(Tm, 1024, F.G, (int)blockIdx.x);
          EpiRes E{(bf16*)(F.ws + WS_XRES), (const float*)(F.ws + WS_MODS) + (size_t)l * 17 * 6144};
          pg8::gemm_phase<EpiRes, pg8::StaticOrder, false, true>(lds, g, S, E, rowcache, F.tid); }
        GRID_BAR();
        RELAUNDER();
        phase_f(F, l, Tm);
        GRID_BAR();
        RELAUNDER();
        load_segt(F, l);
        { pg8::MoeOrder S{8, F.G, (int)blockIdx.x, segt};
          fill_rowcache(F, S);
          pg8::Gemm g{(const pg8::bf16_t*)(F.ws + WS_H), (const pg8::bf16_t*)(F.ws + wsel + WS_W13), 0, 2048, 1024, F8_EX, F8_EW};
          EpiSwiglu E{(bf16*)(F.ws + WS_HID)};
          pg8::gemm_phase<EpiSwiglu, pg8::MoeOrder, true, true>(lds, g, S, E, rowcache, F.tid); }
        GRID_BAR();
        RELAUNDER();
        { pg8::MoeOrder S{4, F.G, (int)blockIdx.x, segt};
          pg8::Gemm g{(const pg8::bf16_t*)(F.ws + WS_HID), (const pg8::bf16_t*)(F.ws + wsel + WS_W2), 0, 1024, 1024, F8_EH, F8_EW};
          EpiPlain E{(unsigned char*)(F.ws + WS_YS)};
          pg8::gemm_phase<EpiPlain, pg8::MoeOrder, false, true>(lds, g, S, E, rowcache, F.tid); }
        GRID_BAR();
    }
    load_segt(F, DEPTH - 1);
    phase_final(F);
    (void)ws16;
}

extern "C" void kernel_launch(void* const* d_in, const int* in_sizes, int n_in, void* d_out, int out_size, void* d_ws, size_t ws_size, hipStream_t stream) {
    static int grid = 0;
    if (grid == 0) {
        if (n_in != 28 || ws_size < WS_END) { fprintf(stderr, "kernel_launch: n_in %d ws %zu (need %zu)\n", n_in, ws_size, (size_t)WS_END); grid = -1; return; }
        int dev = 0, cus = 0, per_cu = 0;
        if (hipGetDevice(&dev) != hipSuccess || hipDeviceGetAttribute(&cus, hipDeviceAttributeMultiprocessorCount, dev) != hipSuccess) { grid = -1; return; }
        if (hipFuncSetAttribute((const void*)fwd_kernel, hipFuncAttributeMaxDynamicSharedMemorySize, LDS_BYTES) != hipSuccess) { fprintf(stderr, "kernel_launch: hipFuncSetAttribute failed\n"); grid = -1; return; }
        if (hipOccupancyMaxActiveBlocksPerMultiprocessor(&per_cu, (const void*)fwd_kernel, NTHREADS, LDS_BYTES) != hipSuccess || per_cu < 1) { fprintf(stderr, "kernel_launch: occupancy query says %d\n", per_cu); }
        (void)hipGetLastError();
        grid = cus;
    }
    if (grid < 0) return;
    (void)hipMemsetAsync((char*)d_ws + WS_CTL, 0, CTL_ZERO_BYTES, stream);
    Args a{};
    for (int i = 0; i < 28; ++i) a.in[i] = (const GAS float*)d_in[i];
    a.out = (GAS float*)d_out; a.ws = (GAS unsigned char*)d_ws;
    hipLaunchKernelGGL(fwd_kernel, dim3(grid), dim3(NTHREADS), LDS_BYTES, stream, a);
    (void)in_sizes; (void)out_size;
}
```
